# Optimizing an MI355X kernel written in HIP

```python
import math
import jax, jax.numpy as jnp
from jax import lax
import numpy as np


D_MODEL = 1024
BATCH = 8
SEQ = 4096
DEPTH = 1

N_META = 16
S5_WIDTH = D_MODEL // 2
S5_GROUP = 16
S5_GROUPS = S5_WIDTH // S5_GROUP
S5_STATE = 64
N_HEADS = D_MODEL // 128
HEAD_DIM = 64
V_DIM = 2 * HEAD_DIM
ATTN_WIDTH = N_HEADS * V_DIM
QK_WIDTH = N_HEADS * 2 * HEAD_DIM
REL_BUCKETS = 32
REL_MAX_DIST = 128
Q_BLOCK = 128
D_FF = 4 * D_MODEL
EPS = 1e-6
OFF_U = 0
OFF_Q = OFF_U + S5_WIDTH
OFF_K = OFF_Q + QK_WIDTH
OFF_V = OFF_K + QK_WIDTH
OFF_GS = OFF_V + ATTN_WIDTH
OFF_GA = OFF_GS + D_MODEL
IN_COLS = OFF_GA + D_MODEL

kernel_name = "hybrid_s5_diffattn_gated_encoder"


def _rmsnorm(x, g):
    xf = x.astype(jnp.float32)
    xf = xf * lax.rsqrt(jnp.mean(xf * xf, axis=-1, keepdims=True) + EPS)
    return xf.astype(x.dtype) * g


def _rel_bucket(rel):
    nb = REL_BUCKETS // 2
    ret = (rel > 0).astype(jnp.int32) * nb
    n = jnp.abs(rel)
    max_exact = nb // 2
    nf = jnp.maximum(n, 1).astype(jnp.float32)
    large = max_exact + (jnp.log(nf / max_exact) / math.log(REL_MAX_DIST / max_exact)
                         * (nb - max_exact)).astype(jnp.int32)
    large = jnp.minimum(large, nb - 1)
    return ret + jnp.where(n < max_exact, n, large)


def _complex_linear_combine(e1, e2):
    a1r, a1i, b1r, b1i = e1
    a2r, a2i, b2r, b2i = e2
    ar = a2r * a1r - a2i * a1i
    ai = a2r * a1i + a2i * a1r
    br = a2r * b1r - a2i * b1i + b2r
    bi = a2r * b1i + a2i * b1r + b2i
    return (ar, ai, br, bi)


def _s5_mixer(u, lam_re, lam_im, log_step, b_re, b_im, c_re, c_im, d_skip):
    bsz, L, _ = u.shape
    ug = u.reshape(bsz, L, S5_GROUPS, S5_GROUP)
    outs = []
    for dr in range(2):
        dt = jnp.exp(log_step[dr])[:, None]
        lr, li = lam_re[dr], lam_im[dr]
        mag = jnp.exp(lr * dt)
        a_re = mag * jnp.cos(li * dt)
        a_im = mag * jnp.sin(li * dt)
        den = lr * lr + li * li
        coef_re = ((a_re - 1.0) * lr + a_im * li) / den
        coef_im = (a_im * lr - (a_re - 1.0) * li) / den
        bu_re = jnp.einsum('blgc,gpc->lbgp', ug, b_re[dr])
        bu_im = jnp.einsum('blgc,gpc->lbgp', ug, b_im[dr])
        xr = coef_re * bu_re - coef_im * bu_im
        xi = coef_re * bu_im + coef_im * bu_re
        if dr == 1:
            xr, xi = xr[::-1], xi[::-1]
        ar = jnp.broadcast_to(a_re[None, None], (L, 1, S5_GROUPS, S5_STATE))
        ai = jnp.broadcast_to(a_im[None, None], (L, 1, S5_GROUPS, S5_STATE))
        _, _, sr, si = lax.associative_scan(_complex_linear_combine, (ar, ai, xr, xi), axis=0)
        if dr == 1:
            sr, si = sr[::-1], si[::-1]
        y_dir = (jnp.einsum('lbgp,gcp->blgc', sr, c_re[dr])
                 - jnp.einsum('lbgp,gcp->blgc', si, c_im[dr]))
        outs.append(y_dir)
    y = (outs[0] + outs[1]).reshape(bsz, L, S5_WIDTH)
    return y + d_skip * u


def _diff_attention(q, k, v, rel_table, lam):
    bsz, L = q.shape[0], q.shape[1]
    n_blk = -(-L // Q_BLOCK)
    Lq = n_blk * Q_BLOCK
    qp = jnp.pad(q, ((0, 0), (0, Lq - L), (0, 0), (0, 0), (0, 0)))
    q_blocks = qp.reshape(bsz, n_blk, Q_BLOCK, N_HEADS, 2, HEAD_DIM).transpose(1, 0, 2, 3, 4, 5)
    pos_blocks = jnp.arange(Lq, dtype=jnp.int32).reshape(n_blk, Q_BLOCK)
    k_pos = jnp.arange(L, dtype=jnp.int32)
    scale = HEAD_DIM ** -0.5
    lam32 = lam.astype(jnp.float32)

    def one_block(args):
        qb, qpos = args
        bucket = _rel_bucket(k_pos[None, :] - qpos[:, None])
        bias = jnp.transpose(rel_table[bucket], (2, 0, 1)).astype(jnp.float32)
        s = jnp.einsum('bqhtd,bkhtd->bhtqk', qb, k,
                       preferred_element_type=jnp.float32) * scale + bias[None, :, None]
        p = jax.nn.softmax(s, axis=-1)
        w = p[:, :, 0] - lam32 * p[:, :, 1]
        return jnp.einsum('bhqk,bkhe->bqhe', w.astype(v.dtype), v)

    o = lax.map(one_block, (q_blocks, pos_blocks))
    o = o.transpose(1, 0, 2, 3, 4).reshape(bsz, Lq, N_HEADS, V_DIM)[:, :L]
    return o


def setup_inputs(seed: int = 0) -> dict:
    key = jax.random.key(seed)
    ks = jax.random.split(key, 26)
    f32 = jnp.float32

    def nrm(k, shape, scale):
        return scale * jax.random.normal(k, shape, f32)

    n_idx = jnp.arange(S5_STATE, dtype=f32)
    sp = (DEPTH, 2, S5_GROUPS, S5_STATE)
    return {
        "x": nrm(ks[0], (BATCH, SEQ, D_MODEL), 1.0),
        "meta_tokens": nrm(ks[1], (N_META, D_MODEL), 1.0),
        "rel_bias_table": nrm(ks[2], (REL_BUCKETS, N_HEADS), 0.5),
        "norm_mix": 1.0 + nrm(ks[3], (DEPTH, D_MODEL), 0.02),
        "w_in": nrm(ks[4], (DEPTH, D_MODEL, IN_COLS), D_MODEL ** -0.5),
        "s5_lambda_re": -0.5 + nrm(ks[5], sp, 0.01),
        "s5_lambda_im": math.pi * n_idx + nrm(ks[6], sp, 0.01),
        "s5_log_step": jax.random.uniform(ks[7], (DEPTH, 2, S5_GROUPS), f32,
                                          minval=math.log(1e-3), maxval=math.log(1e-1)),
        "s5_b_re": nrm(ks[8], (DEPTH, 2, S5_GROUPS, S5_STATE, S5_GROUP), (2 * S5_GROUP) ** -0.5),
        "s5_b_im": nrm(ks[9], (DEPTH, 2, S5_GROUPS, S5_STATE, S5_GROUP), (2 * S5_GROUP) ** -0.5),
        "s5_c_re": nrm(ks[10], (DEPTH, 2, S5_GROUPS, S5_GROUP, S5_STATE), S5_STATE ** -0.5),
        "s5_c_im": nrm(ks[11], (DEPTH, 2, S5_GROUPS, S5_GROUP, S5_STATE), S5_STATE ** -0.5),
        "s5_d": nrm(ks[12], (DEPTH, S5_WIDTH), 1.0),
        "w_glu_a": nrm(ks[13], (DEPTH, S5_WIDTH, D_MODEL), S5_WIDTH ** -0.5),
        "w_glu_b": nrm(ks[14], (DEPTH, S5_WIDTH, D_MODEL), S5_WIDTH ** -0.5),
        "q_norm": 1.0 + nrm(ks[15], (DEPTH, HEAD_DIM), 0.02),
        "k_norm": 1.0 + nrm(ks[16], (DEPTH, HEAD_DIM), 0.02),
        "lambda_q1": nrm(ks[17], (DEPTH, HEAD_DIM), 0.1),
        "lambda_k1": nrm(ks[18], (DEPTH, HEAD_DIM), 0.1),
        "lambda_q2": nrm(ks[19], (DEPTH, HEAD_DIM), 0.1),
        "lambda_k2": nrm(ks[20], (DEPTH, HEAD_DIM), 0.1),
        "attn_subln": 1.0 + nrm(ks[21], (DEPTH, V_DIM), 0.02),
        "w_attn_out": nrm(ks[22], (DEPTH, ATTN_WIDTH, D_MODEL), ATTN_WIDTH ** -0.5),
        "w_o": nrm(ks[23], (DEPTH, D_MODEL, D_MODEL), D_MODEL ** -0.5),
        "norm_ff": 1.0 + nrm(ks[24], (DEPTH, D_MODEL), 0.02),
        "w_ff1": nrm(ks[25], (DEPTH, D_MODEL, D_FF), D_MODEL ** -0.5),
        "w_ff2": nrm(jax.random.fold_in(ks[25], 1), (DEPTH, D_FF, D_MODEL), D_FF ** -0.5),
    }


def reference(x, meta_tokens, rel_bias_table, norm_mix, w_in, s5_lambda_re, s5_lambda_im,
              s5_log_step, s5_b_re, s5_b_im, s5_c_re, s5_c_im, s5_d, w_glu_a, w_glu_b,
              q_norm, k_norm, lambda_q1, lambda_k1, lambda_q2, lambda_k2, attn_subln,
              w_attn_out, w_o, norm_ff, w_ff1, w_ff2):
    bsz = x.shape[0]
    meta = jnp.broadcast_to(meta_tokens[None].astype(x.dtype), (bsz, N_META, D_MODEL))
    h = jnp.concatenate([meta, x], axis=1)
    L = h.shape[1]
    for layer in range(DEPTH):
        lam_init = 0.8 - 0.6 * math.exp(-0.3 * layer)
        hn = _rmsnorm(h, norm_mix[layer])
        proj = hn @ w_in[layer]
        u = proj[..., OFF_U:OFF_Q]
        q = proj[..., OFF_Q:OFF_K].reshape(bsz, L, N_HEADS, 2, HEAD_DIM)
        k = proj[..., OFF_K:OFF_V].reshape(bsz, L, N_HEADS, 2, HEAD_DIM)
        v = proj[..., OFF_V:OFF_GS].reshape(bsz, L, N_HEADS, V_DIM)
        g_s5 = jax.nn.sigmoid(proj[..., OFF_GS:OFF_GA])
        g_attn = jax.nn.sigmoid(proj[..., OFF_GA:IN_COLS])
        y = _s5_mixer(u, s5_lambda_re[layer], s5_lambda_im[layer], s5_log_step[layer],
                      s5_b_re[layer], s5_b_im[layer], s5_c_re[layer], s5_c_im[layer],
                      s5_d[layer])
        y = jax.nn.gelu(y)
        y_s5 = (y @ w_glu_a[layer]) * jax.nn.sigmoid(y @ w_glu_b[layer])
        q = _rmsnorm(q, q_norm[layer])
        k = _rmsnorm(k, k_norm[layer])
        lam = (jnp.exp(jnp.sum(lambda_q1[layer] * lambda_k1[layer]))
               - jnp.exp(jnp.sum(lambda_q2[layer] * lambda_k2[layer])) + lam_init)
        o = _diff_attention(q, k, v, rel_bias_table, lam)
        o = _rmsnorm(o, attn_subln[layer]) * (1.0 - lam_init)
        y_attn = o.reshape(bsz, L, ATTN_WIDTH) @ w_attn_out[layer]
        merged = g_s5 * y_s5 + g_attn * y_attn
        h = h + merged @ w_o[layer]
        hn = _rmsnorm(h, norm_ff[layer])
        h = h + jnp.square(jax.nn.relu(hn @ w_ff1[layer])) @ w_ff2[layer]
    return h[:, N_META:]
```

```cpp
#include <hip/hip_runtime.h>
#include <hip/hip_cooperative_groups.h>
#include <cstdio>
#include <cstdint>
namespace cg = cooperative_groups;

#define LAS __attribute__((address_space(3)))
typedef unsigned short bf16_t;
typedef short bf16x8 __attribute__((ext_vector_type(8)));
typedef float f32x4 __attribute__((ext_vector_type(4)));
typedef float f32x16 __attribute__((ext_vector_type(16)));
typedef unsigned u32x4 __attribute__((ext_vector_type(4)));
typedef unsigned u32x2 __attribute__((ext_vector_type(2)));
typedef float f32x2_t __attribute__((ext_vector_type(2)));
typedef __bf16 bf16x2_t __attribute__((ext_vector_type(2)));

__device__ __forceinline__ unsigned cvtpk(float lo, float hi) { f32x2_t v = {lo, hi}; bf16x2_t b = __builtin_convertvector(v, bf16x2_t); return __builtin_bit_cast(unsigned, b); }
__device__ __forceinline__ float bf2f(unsigned short h) { return __uint_as_float(((unsigned)h) << 16); }
__device__ __forceinline__ float sigmoidf_(float x) { return 1.0f / (1.0f + __expf(-x)); }

constexpr int D = 1024, BATCH = 8, SEQ = 4096, NMETA = 16;
constexpr int MTOK = BATCH * SEQ;
constexpr int MPAD = MTOK + 256;
constexpr int S5W = 512, S5G = 32, S5C = 16, S5P = 64;
constexpr int NH = 8, HD = 64, VD = 128;
constexpr int DFF = 4096;
constexpr int TCH = 32, NCH = SEQ / TCH;
constexpr int KY = TCH * S5C + 4 * S5P;
constexpr float EPS = 1e-6f;
constexpr float LOG2E = 1.4426950408889634f;
constexpr float QSCALE = 0.125f * LOG2E;
constexpr int NLUT = 183;

constexpr size_t MiB = 1u << 20;
constexpr size_t WS_XB = 0;
constexpr size_t WS_SLOC = 0;
constexpr size_t WS_GY = 32 * MiB;
constexpr size_t WS_QO = 65 * MiB;
constexpr size_t WS_KIMG = 129 * MiB;
constexpr size_t WS_VIMG = 193 * MiB;
constexpr size_t WS_KMETA = 257 * MiB;
constexpr size_t WS_VMETA = 257 * MiB + 128 * 1024;
constexpr size_t WS_HBUF = 0;
constexpr size_t WS_G1 = 258 * MiB;
constexpr size_t WS_G2 = 322 * MiB;
constexpr size_t WS_MGT = 386 * MiB;
constexpr size_t WS_UGS = 410 * MiB;
constexpr size_t WS_WSTT = 458 * MiB;
constexpr size_t WS_H1B = 386 * MiB;
constexpr size_t WS_WIN = 466 * MiB;
constexpr size_t WS_WGLU = 477 * MiB;
constexpr size_t WS_WAO = 479 * MiB;
constexpr size_t WS_WWO = 481 * MiB;
constexpr size_t WS_WF1 = 483 * MiB;
constexpr size_t WS_WF2 = 491 * MiB;
constexpr size_t WS_RSTD1 = 499 * MiB;
constexpr size_t WS_SS = WS_RSTD1 + 256 * 1024;
constexpr size_t WS_LUT = WS_SS + 2 * MiB;
constexpr size_t WS_UMETA = WS_LUT + 8 * 1024;
constexpr size_t WS_END = WS_UMETA + 32 * 1024;

namespace pg8 {
constexpr int BM = 256, BK = 64, HALF = 128, HTB = HALF * BK * 2, STAGE_BYTES = 8 * HTB, NXCD = 8, WGM = 8;
__host__ __device__ __forceinline__ int lds_byte(int r, int c) { const int st = (r >> 4) * 2 + (c >> 5), rr = r & 15, cc = c & 31, ob = rr * 64 + cc * 2; return st * 1024 + (ob ^ (((ob >> 9) & 1) << 5)); }
__host__ __device__ __forceinline__ void stage_rc(int b, int& R, int& C) { const int st = b / 1024, sb = b % 1024, swz = sb ^ (((sb >> 9) & 1) << 5); R = (st >> 1) * 16 + swz / 64; C = (st & 1) * 32 + (swz % 64) / 2; }
__host__ __device__ __forceinline__ int perm32(int rho) { const int n = rho >> 4, i = rho & 15; return 8 * (i >> 2) + 4 * n + (i & 3); }

struct Unit { int pm, pn; };
struct Gemm { const bf16_t* A; const bf16_t* Bt; int lda, ldb, K; };

struct StaticOrder {
    int nM, nN, nwg, G, c;
    __device__ void init(int nM_, int nN_, int G_, int c_) { nM = nM_; nN = nN_; nwg = nM * nN; G = G_; c = c_; }
    __device__ bool next(int i, Unit& u) const {
        const long L = (long)i * G + c; if (L >= nwg) return false;
        int wgid = (int)L; { const int q = nwg / NXCD, r = nwg % NXCD, xcd = wgid % NXCD, off = wgid / NXCD; wgid = (xcd < r ? xcd * (q + 1) : r * (q + 1) + (xcd - r) * q) + off; }
        const int nig = WGM * nN, gid = wgid / nig, fm = gid * WGM, gsz = (nM - fm) < WGM ? (nM - fm) : WGM;
        u.pm = fm + ((wgid % nig) % gsz); u.pn = (wgid % nig) / gsz; return true;
    }
};
template <int RM, int CN> struct GroupOrder {
    int G, c;
    __device__ bool next(int i, Unit& u) const {
        const int L = i * G + c; if (L >= 32 * RM * CN) return false;
        const int g = L / (RM * CN), r = L % (RM * CN);
        u.pm = g * RM + r / CN; u.pn = g * CN + r % CN; return true;
    }
};

template <class Epi, class Sched, bool SWAP>
__device__ __forceinline__ void gemm_phase(LAS unsigned char* lds, const Gemm g, const Sched& S, const Epi& E) {
    const int tid = threadIdx.x, wid = __builtin_amdgcn_readfirstlane(tid >> 6), lane = tid & 63, wr = wid >> 2, wc = wid & 3, fr = lane & 15, fq = lane >> 4;
    const int K = g.K, nt = K / BK;
    unsigned voffA[2], voffB[2];
#pragma unroll
    for (int i = 0; i < 2; ++i) { int R, C; stage_rc(tid * 16 + i * 8192, R, C); const int Rb = Epi::PERM ? ((R & ~31) + perm32(R & 31)) : R;
        voffA[i] = (unsigned)(R * g.lda + C) * 2u; voffB[i] = (unsigned)(Rb * g.ldb + C) * 2u; }
    const size_t kstep = (size_t)(BK * 2);
    const size_t hstepA = (size_t)HALF * g.lda * 2, hstepB = (size_t)HALF * g.ldb * 2;
    const size_t tstepA = 2 * hstepA, tstepB = 2 * hstepB;
    const unsigned ldsw = (unsigned)wid * 1024u;
    const int aoff = lds_byte(wr * 64 + fr, fq * 8), boff = lds_byte(wc * 32 + fr, fq * 8);
#define PG8_SA(b, h) (((b) * 2 + (h)) * HTB)
#define PG8_SB(b, h) ((4 + (b) * 2 + (h)) * HTB)
#define PG8_STAGE(bufoff, gbase, voff) do { _Pragma("unroll") for (int _i = 0; _i < 2; ++_i) \
        __builtin_amdgcn_global_load_lds((const unsigned*)((const char*)(gbase) + (voff)[_i]), (LAS unsigned*)(lds + (bufoff) + ldsw + _i * 8192), 16, 0, 0); } while (0)
#define PG8_LDA(dst, b, h) do { _Pragma("unroll") for (int m = 0; m < 4; ++m) _Pragma("unroll") for (int k = 0; k < 2; ++k) dst[m][k] = *(const LAS bf16x8*)(lds + PG8_SA(b, h) + aoff + m * 2048 + k * 1024); } while (0)
#define PG8_LDB(dst, b, h) do { _Pragma("unroll") for (int n = 0; n < 2; ++n) _Pragma("unroll") for (int k = 0; k < 2; ++k) dst[n][k] = *(const LAS bf16x8*)(lds + PG8_SB(b, h) + boff + n * 2048 + k * 1024); } while (0)
#define PG8_MMA(ai, bj, At, Bt) do { __builtin_amdgcn_s_setprio(1); _Pragma("unroll") for (int m = 0; m < 4; ++m) _Pragma("unroll") for (int n = 0; n < 2; ++n) _Pragma("unroll") for (int k = 0; k < 2; ++k) \
        acc[ai][bj][m][n] = SWAP ? __builtin_amdgcn_mfma_f32_16x16x32_bf16(At[m][k], Bt[n][k], acc[ai][bj][m][n], 0, 0, 0) \
                                 : __builtin_amdgcn_mfma_f32_16x16x32_bf16(Bt[n][k], At[m][k], acc[ai][bj][m][n], 0, 0, 0); __builtin_amdgcn_s_setprio(0); } while (0)
#define PG8_WAIT_V(n) asm volatile("s_waitcnt vmcnt(" #n ")" ::: "memory")
#define PG8_WAIT_L(n) asm volatile("s_waitcnt lgkmcnt(" #n ")" ::: "memory")
#define PG8_BAR __builtin_amdgcn_s_barrier()
#define PG8_SCHED __builtin_amdgcn_sched_barrier(0)
    Unit cur, nxt; int ui = 0;
    if (!S.next(0, cur)) return;
    f32x4 acc[2][2][4][2];
#pragma unroll
    for (int a = 0; a < 2; ++a)
#pragma unroll
        for (int b = 0; b < 2; ++b)
#pragma unroll
            for (int m = 0; m < 4; ++m)
#pragma unroll
                for (int n = 0; n < 2; ++n) acc[a][b][m][n] = (f32x4){0.f, 0.f, 0.f, 0.f};
    bf16x8 At[4][2], B0[2][2], B1[2][2];
    const char* cA = (const char*)g.A + (size_t)cur.pm * tstepA; const char* cB = (const char*)g.Bt + (size_t)cur.pn * tstepB;
    PG8_STAGE(PG8_SB(0, 0), cB, voffB); PG8_STAGE(PG8_SB(0, 1), cB + hstepB, voffB); PG8_STAGE(PG8_SA(0, 0), cA, voffA); PG8_STAGE(PG8_SA(0, 1), cA + hstepA, voffA);
    if (wr == 1) PG8_BAR;
    PG8_WAIT_V(2); PG8_BAR;
    PG8_STAGE(PG8_SB(1, 0), cB + kstep, voffB); PG8_STAGE(PG8_SA(1, 0), cA + kstep, voffA); PG8_STAGE(PG8_SB(1, 1), cB + hstepB + kstep, voffB);
    PG8_WAIT_V(6); PG8_BAR;
    for (;;) {
        const bool has_next = S.next(ui + 1, nxt);
        const char* nA = has_next ? (const char*)g.A + (size_t)nxt.pm * tstepA : cA; const char* nB = has_next ? (const char*)g.Bt + (size_t)nxt.pn * tstepB : cB;
        for (int t = 0; t < nt; t += 2) {
            const bool last = (t == nt - 2);
            const char* a1 = cA + (size_t)(t + 1) * kstep;
            const char* a2 = last ? nA : cA + (size_t)(t + 2) * kstep; const char* b2 = last ? nB : cB + (size_t)(t + 2) * kstep;
            const char* a3 = a2 + kstep; const char* b3 = b2 + kstep;
            PG8_LDB(B0, 0, 0); PG8_LDB(B1, 0, 1); PG8_SCHED; PG8_LDA(At, 0, 0); PG8_STAGE(PG8_SA(1, 1), a1 + hstepA, voffA);
            PG8_WAIT_V(8); PG8_WAIT_L(0); PG8_BAR; PG8_MMA(0, 0, At, B0); PG8_MMA(0, 1, At, B1); PG8_BAR; PG8_SCHED;
            PG8_LDA(At, 0, 1); PG8_STAGE(PG8_SB(0, 0), b2, voffB); PG8_STAGE(PG8_SB(0, 1), b2 + hstepB, voffB); PG8_STAGE(PG8_SA(0, 0), a2, voffA);
            PG8_WAIT_V(8); PG8_WAIT_L(0); PG8_BAR; PG8_MMA(1, 0, At, B0); PG8_MMA(1, 1, At, B1); PG8_BAR; PG8_SCHED;
            PG8_LDB(B0, 1, 0); PG8_LDB(B1, 1, 1); PG8_SCHED; PG8_LDA(At, 1, 0); PG8_STAGE(PG8_SA(0, 1), a2 + hstepA, voffA);
            PG8_WAIT_V(8); PG8_WAIT_L(0); PG8_BAR; PG8_MMA(0, 0, At, B0); PG8_MMA(0, 1, At, B1); PG8_BAR; PG8_SCHED;
            PG8_LDA(At, 1, 1); PG8_STAGE(PG8_SB(1, 0), b3, voffB); PG8_STAGE(PG8_SB(1, 1), b3 + hstepB, voffB); PG8_STAGE(PG8_SA(1, 0), a3, voffA);
            PG8_WAIT_V(8); PG8_WAIT_L(0); PG8_BAR; PG8_MMA(1, 0, At, B0); PG8_MMA(1, 1, At, B1); PG8_BAR; PG8_SCHED;
        }
        if (wr == 0) PG8_BAR;
        { int le = lane; asm volatile("" : "+v"(le)); E(acc, cur, wr, wc, le & 15, le >> 4); }
        if (!has_next) break;
#pragma unroll
        for (int a = 0; a < 2; ++a)
#pragma unroll
            for (int b = 0; b < 2; ++b)
#pragma unroll
                for (int m = 0; m < 4; ++m)
#pragma unroll
                    for (int n = 0; n < 2; ++n) acc[a][b][m][n] = (f32x4){0.f, 0.f, 0.f, 0.f};
        cur = nxt; cA = nA; cB = nB; ++ui;
        if (wr == 1) PG8_BAR;
    }
    PG8_WAIT_V(0);
    PG8_BAR;
#undef PG8_SA
#undef PG8_SB
#undef PG8_STAGE
#undef PG8_LDA
#undef PG8_LDB
#undef PG8_MMA
#undef PG8_WAIT_V
#undef PG8_WAIT_L
#undef PG8_BAR
#undef PG8_SCHED
}
}
using pg8::Unit;

__device__ __forceinline__ int pi_slot(int k) { return (k & ~12) | ((k & 4) << 1) | ((k & 8) >> 1); }
__device__ __forceinline__ u32x4 pack8(const f32x4 a, const f32x4 b) { u32x4 w; w.x = cvtpk(a[0], a[1]); w.y = cvtpk(a[2], a[3]); w.z = cvtpk(b[0], b[1]); w.w = cvtpk(b[2], b[3]); return w; }

struct EpiInMain {
    static constexpr bool PERM = true;
    const float* rstd1; bf16_t* ugs; float* umeta; bf16_t* qbuf; bf16_t* kimg; bf16_t* kmeta; bf16_t* g1; bf16_t* g2; const float* qn; const float* kn;
    __device__ __forceinline__ void operator()(const f32x4 (&acc)[2][2][4][2], const Unit& u, int wr, int wc, int fr, int fq) const {
        const int pn = u.pn, pm = u.pm; const bool meta = (pm == MTOK / 256);
        const int b = pm >> 4;
#pragma unroll
        for (int ai = 0; ai < 2; ++ai)
#pragma unroll
            for (int m = 0; m < 4; ++m) {
                const int rloc = ai * 128 + wr * 64 + m * 16 + fr;
                const int r = pm * 256 + rloc;
                const int j = (pm & 15) * 256 + rloc;
                const float rs = rstd1[r];
                f32x4 v[2][2];
#pragma unroll
                for (int bj = 0; bj < 2; ++bj)
#pragma unroll
                    for (int n = 0; n < 2; ++n) v[bj][n] = acc[ai][bj][m][n] * rs;
                if (pn < 2) {
#pragma unroll
                    for (int bj = 0; bj < 2; ++bj) {
                        const int c = 256 * pn + 64 * wc + 32 * bj + 8 * fq;
                        if (!meta) { const int gg = c >> 4, c0 = c & 15;
                            bf16_t* dst = ugs + ((size_t)gg * (BATCH * NCH) + b * NCH + (j >> 5)) * KY + (j & 31) * 16 + c0;
                            *(u32x4*)dst = pack8(v[bj][0], v[bj][1]);
                        } else if (rloc < NMETA) { float* dst = umeta + rloc * S5W + c; *(f32x4*)dst = v[bj][0]; *(f32x4*)(dst + 4) = v[bj][1]; }
                    }
                } else if (pn < 10) {
                    float ss = 0.f;
#pragma unroll
                    for (int bj = 0; bj < 2; ++bj)
#pragma unroll
                        for (int n = 0; n < 2; ++n) { const f32x4 x = v[bj][n]; ss += (x[0] * x[0] + x[1] * x[1]) + (x[2] * x[2] + x[3] * x[3]); }
                    ss += __shfl_xor(ss, 16); ss += __shfl_xor(ss, 32);
                    const float sc = rsqrtf(ss * (1.0f / 64.0f) + EPS) * ((pn < 6) ? QSCALE : 1.0f);
                    const float* gp = (pn < 6) ? qn : kn;
#pragma unroll
                    for (int bj = 0; bj < 2; ++bj) {
                        const f32x4 ga = *(const f32x4*)(gp + 32 * bj + 8 * fq), gb = *(const f32x4*)(gp + 32 * bj + 8 * fq + 4);
                        const f32x4 o0 = v[bj][0] * ga * sc, o1 = v[bj][1] * gb * sc;
                        const u32x4 w = pack8(o0, o1);
                        if (pn < 6) { if (!meta) { const int cq = 256 * (pn - 2) + 64 * wc + 32 * bj + 8 * fq; *(u32x4*)(qbuf + (size_t)r * 1024 + cq) = w; } }
                        else { const int h = 2 * (pn - 6) + (wc >> 1), chunk = 8 * (wc & 1) + 4 * bj + fq;
                            if (!meta) { const int tile = j >> 6, slot = pi_slot(j & 63);
                                *(u32x4*)(kimg + ((((size_t)(b * NH + h) * 64 + tile) * 16 + chunk) * 64 + slot) * 8) = w;
                            } else if (rloc < 64) { *(u32x4*)(kmeta + (((size_t)h * 16 + chunk) * 64 + pi_slot(rloc)) * 8) = w; } }
                    }
                } else {
                    if (!meta) { bf16_t* gb = (pn < 14) ? g1 : g2; const int pg = (pn < 14) ? pn - 10 : pn - 14;
#pragma unroll
                        for (int bj = 0; bj < 2; ++bj) { f32x4 o0, o1;
#pragma unroll
                            for (int i = 0; i < 4; ++i) { o0[i] = sigmoidf_(v[bj][0][i]); o1[i] = sigmoidf_(v[bj][1][i]); }
                            *(u32x4*)(gb + (size_t)r * 1024 + 256 * pg + 64 * wc + 32 * bj + 8 * fq) = pack8(o0, o1); } }
                }
            }
    }
};
struct EpiInV {
    static constexpr bool PERM = false;
    const float* rstd1; bf16_t* vimg; bf16_t* vmeta;
    __device__ __forceinline__ void operator()(const f32x4 (&acc)[2][2][4][2], const Unit& u, int wr, int wc, int fr, int fq) const {
        const int pn = u.pn, pm = u.pm; const bool meta = (pm == MTOK / 256); const int b = pm >> 4;
#pragma unroll
        for (int ai = 0; ai < 2; ++ai) {
            if (meta && (ai | wr)) continue;
            const int tile = (pm & 15) * 4 + 2 * ai + wr;
#pragma unroll
            for (int m = 0; m < 4; ++m) {
                const int r0 = pm * 256 + ai * 128 + wr * 64 + m * 16 + 4 * fq;
                const f32x4 rs = *(const f32x4*)(rstd1 + r0);
                const int kvchunk = 2 * m + (fq >> 1), within = 4 * (fq & 1);
#pragma unroll
                for (int bj = 0; bj < 2; ++bj)
#pragma unroll
                    for (int n = 0; n < 2; ++n) {
                        const int h = 2 * pn + bj, e = 32 * wc + 16 * n + fr;
                        const f32x4 x = acc[ai][bj][m][n] * rs;
                        u32x2 w; w.x = cvtpk(x[0], x[1]); w.y = cvtpk(x[2], x[3]);
                        bf16_t* dst = meta ? vmeta + (((size_t)h * 8 + kvchunk) * 128 + e) * 8 + within
                                           : vimg + ((((size_t)(b * NH + h) * 64 + tile) * 8 + kvchunk) * 128 + e) * 8 + within;
                        *(u32x2*)dst = w;
                    }
            }
        }
    }
};
struct EpiSloc {
    static constexpr bool PERM = true;
    float* sloc;
    __device__ __forceinline__ void operator()(const f32x4 (&acc)[2][2][4][2], const Unit& u, int wr, int wc, int fr, int fq) const {
#pragma unroll
        for (int ai = 0; ai < 2; ++ai)
#pragma unroll
            for (int m = 0; m < 4; ++m) { const int r = u.pm * 256 + ai * 128 + wr * 64 + m * 16 + fr;
#pragma unroll
                for (int bj = 0; bj < 2; ++bj) { float* dst = sloc + (size_t)r * 256 + 128 * bj + 32 * wc + 8 * fq;
                    *(f32x4*)dst = acc[ai][bj][m][0]; *(f32x4*)(dst + 4) = acc[ai][bj][m][1]; } }
    }
};
__device__ __forceinline__ float gelu_tanh(float x) { const float u = 0.7978845608028654f * (x + 0.044715f * x * x * x); return x / (1.0f + __expf(-2.0f * u)); }
struct EpiY {
    static constexpr bool PERM = true;
    bf16_t* gy;
    __device__ __forceinline__ void operator()(const f32x4 (&acc)[2][2][4][2], const Unit& u, int wr, int wc, int fr, int fq) const {
        const int g = u.pm >> 2;
#pragma unroll
        for (int ai = 0; ai < 2; ++ai)
#pragma unroll
            for (int m = 0; m < 4; ++m) { const int rg = (u.pm & 3) * 256 + ai * 128 + wr * 64 + m * 16 + fr;
                const int b = rg >> 7, ch = rg & 127;
#pragma unroll
                for (int bj = 0; bj < 2; ++bj) { const int n0 = 256 * (u.pn & 1) + 128 * bj + 32 * wc + 8 * fq; const int tp = n0 >> 4, c0 = n0 & 15;
                    f32x4 o0, o1;
#pragma unroll
                    for (int i = 0; i < 4; ++i) { o0[i] = gelu_tanh(acc[ai][bj][m][0][i]); o1[i] = gelu_tanh(acc[ai][bj][m][1][i]); }
                    *(u32x4*)(gy + ((size_t)b * SEQ + ch * TCH + tp) * S5W + g * 16 + c0) = pack8(o0, o1); } }
    }
};
struct EpiGlu {
    static constexpr bool PERM = true;
    bf16_t* g1;
    __device__ __forceinline__ void operator()(const f32x4 (&acc)[2][2][4][2], const Unit& u, int wr, int wc, int fr, int fq) const {
#pragma unroll
        for (int ai = 0; ai < 2; ++ai)
#pragma unroll
            for (int m = 0; m < 4; ++m) { const int r = u.pm * 256 + ai * 128 + wr * 64 + m * 16 + fr;
                bf16_t* p = g1 + (size_t)r * 1024 + 128 * u.pn + 32 * wc + 8 * fq;
                const u32x4 gv = *(const u32x4*)p; f32x4 o0, o1;
#pragma unroll
                for (int i = 0; i < 4; ++i) {
                    const unsigned w0 = gv[i >> 1], w1 = gv[2 + (i >> 1)];
                    const float ga = (i & 1) ? __uint_as_float(w0 & 0xffff0000u) : __uint_as_float(w0 << 16);
                    const float gb = (i & 1) ? __uint_as_float(w1 & 0xffff0000u) : __uint_as_float(w1 << 16);
                    o0[i] = acc[ai][0][m][0][i] * sigmoidf_(acc[ai][1][m][0][i]) * ga;
                    o1[i] = acc[ai][0][m][1][i] * sigmoidf_(acc[ai][1][m][1][i]) * gb; }
                *(u32x4*)p = pack8(o0, o1); }
    }
};
struct EpiAo {
    static constexpr bool PERM = true;
    const bf16_t* t2; bf16_t* g2;
    __device__ __forceinline__ void operator()(const f32x4 (&acc)[2][2][4][2], const Unit& u, int wr, int wc, int fr, int fq) const {
#pragma unroll
        for (int ai = 0; ai < 2; ++ai)
#pragma unroll
            for (int m = 0; m < 4; ++m) { const int r = u.pm * 256 + ai * 128 + wr * 64 + m * 16 + fr;
#pragma unroll
                for (int bj = 0; bj < 2; ++bj) { const size_t off = (size_t)r * 1024 + 256 * u.pn + 128 * bj + 32 * wc + 8 * fq;
                    const u32x4 gv = *(const u32x4*)(g2 + off), tv = *(const u32x4*)(t2 + off); f32x4 o0, o1;
#pragma unroll
                    for (int i = 0; i < 4; ++i) {
                        const unsigned g0 = gv[i >> 1], g1w = gv[2 + (i >> 1)], t0 = tv[i >> 1], t1 = tv[2 + (i >> 1)];
                        const float ga = (i & 1) ? __uint_as_float(g0 & 0xffff0000u) : __uint_as_float(g0 << 16);
                        const float gb = (i & 1) ? __uint_as_float(g1w & 0xffff0000u) : __uint_as_float(g1w << 16);
                        const float ta = (i & 1) ? __uint_as_float(t0 & 0xffff0000u) : __uint_as_float(t0 << 16);
                        const float tb = (i & 1) ? __uint_as_float(t1 & 0xffff0000u) : __uint_as_float(t1 << 16);
                        o0[i] = ta + ga * acc[ai][bj][m][0][i]; o1[i] = tb + gb * acc[ai][bj][m][1][i]; }
                    *(u32x4*)(g2 + off) = pack8(o0, o1); } }
    }
};
struct EpiWo {
    static constexpr bool PERM = false;
    const float* x; float* out; bf16_t* h1b; float* ss;
    __device__ __forceinline__ void operator()(const f32x4 (&acc)[2][2][4][2], const Unit& u, int wr, int wc, int fr, int fq) const {
#pragma unroll
        for (int ai = 0; ai < 2; ++ai)
#pragma unroll
            for (int m = 0; m < 4; ++m) { const int r = u.pm * 256 + ai * 128 + wr * 64 + m * 16 + fr; float sq = 0.f;
#pragma unroll
                for (int bj = 0; bj < 2; ++bj)
#pragma unroll
                    for (int n = 0; n < 2; ++n) { const size_t off = (size_t)r * 1024 + 256 * u.pn + 128 * bj + 32 * wc + 16 * n + 4 * fq;
                        const f32x4 h = *(const f32x4*)(x + off) + acc[ai][bj][m][n];
                        *(f32x4*)(out + off) = h; u32x2 w; w.x = cvtpk(h[0], h[1]); w.y = cvtpk(h[2], h[3]); *(u32x2*)(h1b + off) = w;
                        sq += (h[0] * h[0] + h[1] * h[1]) + (h[2] * h[2] + h[3] * h[3]); }
                sq += __shfl_xor(sq, 16); sq += __shfl_xor(sq, 32);
                if (fq == 0) ss[(size_t)r * 16 + u.pn * 4 + wc] = sq; }
    }
};
struct EpiF1 {
    static constexpr bool PERM = true;
    const float* ss; bf16_t* hb;
    __device__ __forceinline__ void operator()(const f32x4 (&acc)[2][2][4][2], const Unit& u, int wr, int wc, int fr, int fq) const {
#pragma unroll
        for (int ai = 0; ai < 2; ++ai)
#pragma unroll
            for (int m = 0; m < 4; ++m) { const int r = u.pm * 256 + ai * 128 + wr * 64 + m * 16 + fr;
                const f32x4* sp = (const f32x4*)(ss + (size_t)r * 16); const f32x4 s0 = sp[0], s1 = sp[1], s2 = sp[2], s3 = sp[3];
                const float tot = ((s0[0] + s0[1]) + (s0[2] + s0[3])) + ((s1[0] + s1[1]) + (s1[2] + s1[3])) + ((s2[0] + s2[1]) + (s2[2] + s2[3])) + ((s3[0] + s3[1]) + (s3[2] + s3[3]));
                const float rs = rsqrtf(tot * (1.0f / 1024.0f) + EPS);
#pragma unroll
                for (int bj = 0; bj < 2; ++bj) { f32x4 o0, o1;
#pragma unroll
                    for (int i = 0; i < 4; ++i) { const float a0 = fmaxf(acc[ai][bj][m][0][i] * rs, 0.f), a1 = fmaxf(acc[ai][bj][m][1][i] * rs, 0.f); o0[i] = a0 * a0; o1[i] = a1 * a1; }
                    *(u32x4*)(hb + (size_t)r * DFF + 256 * u.pn + 128 * bj + 32 * wc + 8 * fq) = pack8(o0, o1); } }
    }
};
struct EpiF2 {
    static constexpr bool PERM = false;
    float* out;
    __device__ __forceinline__ void operator()(const f32x4 (&acc)[2][2][4][2], const Unit& u, int wr, int wc, int fr, int fq) const {
#pragma unroll
        for (int ai = 0; ai < 2; ++ai)
#pragma unroll
            for (int m = 0; m < 4; ++m) { const int r = u.pm * 256 + ai * 128 + wr * 64 + m * 16 + fr;
#pragma unroll
                for (int bj = 0; bj < 2; ++bj)
#pragma unroll
                    for (int n = 0; n < 2; ++n) { float* p = out + (size_t)r * 1024 + 256 * u.pn + 128 * bj + 32 * wc + 16 * n + 4 * fq;
                        *(f32x4*)p = *(const f32x4*)p + acc[ai][bj][m][n]; } }
    }
};

template <bool SLOW>
__device__ __forceinline__ void attn_tile(const LAS unsigned char* kb, const LAS unsigned char* vb, const bf16x8 (&qf)[4], f32x16 (&o)[4], float& l,
                                          float cinit, int relb, int nvalid, const LAS float* lut, int i32, int hi) {
    f32x16 s0, s1;
#pragma unroll
    for (int r = 0; r < 16; ++r) { s0[r] = SLOW ? 0.f : cinit; s1[r] = SLOW ? 0.f : cinit; }
#pragma unroll
    for (int ds = 0; ds < 4; ++ds) {
        const bf16x8 k0 = *(const LAS bf16x8*)(kb + ((2 * ds + hi) * 64 + i32) * 16);
        const bf16x8 k1 = *(const LAS bf16x8*)(kb + ((2 * ds + hi) * 64 + 32 + i32) * 16);
        s0 = __builtin_amdgcn_mfma_f32_32x32x16_bf16(k0, qf[ds], s0, 0, 0, 0);
        s1 = __builtin_amdgcn_mfma_f32_32x32x16_bf16(k1, qf[ds], s1, 0, 0, 0);
    }
    if (SLOW) {
        const int base = relb + 8 * hi - i32 + 91;
#pragma unroll
        for (int r = 0; r < 16; ++r) {
            const int kap = (r & 3) + 4 * ((r >> 2) & 1) + 16 * (r >> 3);
            int i0 = base + kap, i1 = base + kap + 32;
            i0 = i0 < 0 ? 0 : (i0 > NLUT - 1 ? NLUT - 1 : i0); i1 = i1 < 0 ? 0 : (i1 > NLUT - 1 ? NLUT - 1 : i1);
            const float b0 = lut[i0], b1 = lut[i1];
            s0[r] = (kap + 8 * hi < nvalid) ? s0[r] + b0 : -INFINITY;
            s1[r] = (kap + 8 * hi + 32 < nvalid) ? s1[r] + b1 : -INFINITY;
        }
    }
    float sum = 0.f;
#pragma unroll
    for (int r = 0; r < 16; ++r) { s0[r] = __builtin_amdgcn_exp2f(s0[r]); s1[r] = __builtin_amdgcn_exp2f(s1[r]); sum += s0[r] + s1[r]; }
    l += sum;
    u32x4 pw[4];
#pragma unroll
    for (int i = 0; i < 4; ++i) { pw[0][i] = cvtpk(s0[2 * i], s0[2 * i + 1]); pw[1][i] = cvtpk(s0[8 + 2 * i], s0[8 + 2 * i + 1]);
                                  pw[2][i] = cvtpk(s1[2 * i], s1[2 * i + 1]); pw[3][i] = cvtpk(s1[8 + 2 * i], s1[8 + 2 * i + 1]); }
    if (SLOW) __builtin_amdgcn_sched_barrier(0);
#pragma unroll
    for (int eb = 0; eb < 4; ++eb)
#pragma unroll
        for (int s = 0; s < 4; ++s) {
            const bf16x8 vf = *(const LAS bf16x8*)(vb + ((2 * s + hi) * 128 + 32 * eb + i32) * 16);
            o[eb] = __builtin_amdgcn_mfma_f32_32x32x16_bf16(vf, __builtin_bit_cast(bf16x8, pw[s]), o[eb], 0, 0, 0);
        }
}

constexpr int ATT_KB = 0, ATT_VB = 32768, ATT_LUT = 65536, ATT_CMB = 67584;
__device__ __forceinline__ void attn_unit(LAS unsigned char* lds, int bh, int qb, bf16_t* qo, const bf16_t* kimg, const bf16_t* vimg, const bf16_t* kmeta, const bf16_t* vmeta,
                                          const float* lutg) {
    const int tid = threadIdx.x; int lane = tid & 63; asm volatile("" : "+v"(lane));
    const int i32 = lane & 31, hi = lane >> 5; const int wid = __builtin_amdgcn_readfirstlane(tid >> 6);
    const int b = bh >> 3, h = bh & 7, t = wid >> 2, qblk = wid & 3;
    const int q0 = qb * 128 + qblk * 32;
    const float lam = lutg[NH * NLUT];
    LAS float* lut = (LAS float*)(lds + ATT_LUT);
    if (tid < NLUT) lut[tid] = lutg[h * NLUT + tid];
    const unsigned char* ksrc = (const unsigned char*)kimg + (size_t)bh * 64 * 16384;
    const unsigned char* vsrc = (const unsigned char*)vimg + (size_t)bh * 64 * 16384;
    const unsigned char* kms = (const unsigned char*)kmeta + (size_t)h * 16384;
    const unsigned char* vms = (const unsigned char*)vmeta + (size_t)h * 16384;
#define ATT_DMA(j, buf) do { const unsigned char* ks_ = ((j) < 64) ? ksrc + (size_t)(j) * 16384 : kms; const unsigned char* vs_ = ((j) < 64) ? vsrc + (size_t)(j) * 16384 : vms; \
        _Pragma("unroll") for (int p_ = 0; p_ < 2; ++p_) { const int pc_ = wid + 8 * p_; \
            __builtin_amdgcn_global_load_lds((const unsigned*)(ks_ + pc_ * 1024 + lane * 16), (LAS unsigned*)(lds + ATT_KB + (buf) * 16384 + pc_ * 1024), 16, 0, 0); \
            __builtin_amdgcn_global_load_lds((const unsigned*)(vs_ + pc_ * 1024 + lane * 16), (LAS unsigned*)(lds + ATT_VB + (buf) * 16384 + pc_ * 1024), 16, 0, 0); } } while (0)
    ATT_DMA(0, 0);
    bf16x8 qf[4];
    { const bf16_t* qp = qo + ((size_t)b * SEQ + q0 + i32) * 1024 + h * 128 + t * 64 + hi * 8;
#pragma unroll
      for (int ds = 0; ds < 4; ++ds) qf[ds] = *(const bf16x8*)(qp + ds * 16); }
    f32x16 o[4];
#pragma unroll
    for (int eb = 0; eb < 4; ++eb)
#pragma unroll
        for (int r = 0; r < 16; ++r) o[eb][r] = 0.f;
    float l = 0.f;
    asm volatile("s_waitcnt vmcnt(0)" ::: "memory");
    __syncthreads();
    const float cneg = lut[0], cpos = lut[NLUT - 1];
    for (int j = 0; j < 65; ++j) {
        const int buf = j & 1;
        if (j + 1 < 65) ATT_DMA(j + 1, buf ^ 1);
        const LAS unsigned char* kb = lds + ATT_KB + buf * 16384 + t * 8192; const LAS unsigned char* vb = lds + ATT_VB + buf * 16384;
        const int lo = 64 * j - (q0 + 31), hi_ = 64 * j + 63 - q0;
        if (j < 64 && (hi_ <= -91 || lo >= 91)) attn_tile<false>(kb, vb, qf, o, l, (hi_ <= -91) ? cneg : cpos, 0, 64, lut, i32, hi);
        else attn_tile<true>(kb, vb, qf, o, l, 0.f, (j < 64) ? 64 * j - q0 : -NMETA - q0, (j < 64) ? 64 : NMETA, lut, i32, hi);
        asm volatile("s_waitcnt vmcnt(0)" ::: "memory");
        __syncthreads();
    }
#undef ATT_DMA
    const float lt = l + __shfl_xor(l, 32);
    LAS float* cmb = (LAS float*)(lds + ATT_CMB) + qblk * 4096 + lane;
    if (t == 1) { const float sc = lam / lt;
#pragma unroll
        for (int eb = 0; eb < 4; ++eb)
#pragma unroll
            for (int r = 0; r < 16; ++r) cmb[(eb * 16 + r) * 64] = o[eb][r] * sc; }
    __syncthreads();
    if (t == 0) { const float sc = 1.0f / lt; float ssq = 0.f;
#pragma unroll
        for (int eb = 0; eb < 4; ++eb)
#pragma unroll
            for (int r = 0; r < 16; ++r) { const float v = o[eb][r] * sc - cmb[(eb * 16 + r) * 64]; o[eb][r] = v; ssq += v * v; }
        ssq += __shfl_xor(ssq, 32);
        const float rs = rsqrtf(ssq * (1.0f / 128.0f) + EPS);
        bf16_t* op = qo + ((size_t)b * SEQ + q0 + i32) * 1024 + h * 128 + 4 * hi;
#pragma unroll
        for (int eb = 0; eb < 4; ++eb)
#pragma unroll
            for (int g = 0; g < 4; ++g) { u32x2 w; w.x = cvtpk(o[eb][4 * g] * rs, o[eb][4 * g + 1] * rs); w.y = cvtpk(o[eb][4 * g + 2] * rs, o[eb][4 * g + 3] * rs);
                *(u32x2*)(op + 32 * eb + 8 * g) = w; }
    }
}

struct Params {
    const float* in[27]; float* out; unsigned char* ws;
};
__device__ __forceinline__ float wave_sum(float v) {
#pragma unroll
    for (int o = 1; o < 64; o <<= 1) v += __shfl_xor(v, o);
    return v;
}
__device__ __forceinline__ void tr_item(const float* W, int ldw, int col0, int k0, bf16_t* WT, int K, int n0, const float* ksc, int kmask, float kmul, LAS float* scr, int lane) {
#pragma unroll 8
    for (int i = 0; i < 32; ++i) { const int kk = 2 * i + (lane >> 5); float s = kmul; if (ksc) s *= ksc[(k0 + kk) & kmask];
        scr[kk * 33 + (lane & 31)] = W[(size_t)(k0 + kk) * ldw + col0 + (lane & 31)] * s; }
    asm volatile("s_waitcnt lgkmcnt(0)" ::: "memory");
    const int c = lane & 7;
#pragma unroll
    for (int jj = 0; jj < 4; ++jj) { const int n = (lane >> 3) + 8 * jj; const LAS float* s = scr + (8 * c) * 33 + n;
        u32x4 o; o.x = cvtpk(s[0 * 33], s[1 * 33]); o.y = cvtpk(s[2 * 33], s[3 * 33]); o.z = cvtpk(s[4 * 33], s[5 * 33]); o.w = cvtpk(s[6 * 33], s[7 * 33]);
        *(u32x4*)(WT + (size_t)(n0 + n) * K + k0 + 8 * c) = o; }
    asm volatile("s_waitcnt lgkmcnt(0)" ::: "memory");
}
__device__ __forceinline__ int rel_bucket(int rel) {
    const int n = rel < 0 ? -rel : rel; int bk;
    if (n < 8) bk = n; else { bk = (31 - __builtin_clz((unsigned)(n * n))) + 2; if (bk > 15) bk = 15; }
    return (rel > 0 ? 16 : 0) + bk;
}

__device__ __forceinline__ void s5_prep_group(const Params& P, int g, LAS unsigned char* lds) {
    const float* lam_re = P.in[5]; const float* lam_im = P.in[6]; const float* log_step = P.in[7];
    const float* b_re = P.in[8]; const float* b_im = P.in[9]; const float* c_re = P.in[10]; const float* c_im = P.in[11]; const float* dsk = P.in[12];
    bf16_t* mgt = (bf16_t*)(P.ws + WS_MGT) + (size_t)g * 512 * KY;
    bf16_t* wst = (bf16_t*)(P.ws + WS_WSTT) + (size_t)g * 256 * 512;
    const int tid = threadIdx.x;
    LAS float* apw = (LAS float*)lds;
    LAS float* coef = apw + 2 * 33 * 64 * 2;
    LAS float* kt = coef + 2 * 64 * 2;
    for (int idx = tid; idx < 2 * 33 * 64; idx += 512) {
        const int p = idx & 63, tau = (idx >> 6) % 33, dr = idx / (33 * 64);
        const float dt = expf(log_step[dr * S5G + g]); const float lr = lam_re[(dr * S5G + g) * S5P + p], li = lam_im[(dr * S5G + g) * S5P + p];
        const float mag = expf(lr * dt * (float)tau); float sn, cs; sincosf(li * dt * (float)tau, &sn, &cs);
        apw[idx * 2] = mag * cs; apw[idx * 2 + 1] = mag * sn;
        if (tau == 1) { const float ar = mag * cs, aim = mag * sn, den = lr * lr + li * li;
            coef[(dr * 64 + p) * 2] = ((ar - 1.0f) * lr + aim * li) / den; coef[(dr * 64 + p) * 2 + 1] = (aim * lr - (ar - 1.0f) * li) / den; }
    }
    __syncthreads();
    {
        const int dr = tid >> 8, cp = (tid >> 4) & 15, c = tid & 15;
        float a[32];
#pragma unroll
        for (int t = 0; t < 32; ++t) a[t] = 0.f;
        for (int p = 0; p < 64; ++p) {
            const float cr = c_re[((dr * S5G + g) * S5C + cp) * S5P + p], ci = c_im[((dr * S5G + g) * S5C + cp) * S5P + p];
            const float br = b_re[((dr * S5G + g) * S5P + p) * S5C + c], bi = b_im[((dr * S5G + g) * S5P + p) * S5C + c];
            const float kr = coef[(dr * 64 + p) * 2], ki = coef[(dr * 64 + p) * 2 + 1];
            const float btr = kr * br - ki * bi, bti = kr * bi + ki * br;
            const float wr_ = cr * btr - ci * bti, wi_ = cr * bti + ci * btr;
#pragma unroll
            for (int t = 0; t < 32; ++t) { const float pr = apw[((dr * 33 + t) * 64 + p) * 2], pim = apw[((dr * 33 + t) * 64 + p) * 2 + 1]; a[t] += wr_ * pr - wi_ * pim; }
        }
#pragma unroll
        for (int t = 0; t < 32; ++t) kt[(dr * 32 + t) * 256 + cp * 16 + c] = a[t];
    }
    __syncthreads();
    for (int idx = tid; idx < 512 * 64; idx += 512) {
        const int n = idx >> 6, kc = idx & 63, tp = n >> 4, cp = n & 15, t = kc >> 1, c0 = (kc & 1) * 8, tau = tp - t;
        float v[8];
#pragma unroll
        for (int i = 0; i < 8; ++i) { const int c = c0 + i; float x;
            if (tau > 0) x = kt[(0 * 32 + tau) * 256 + cp * 16 + c]; else if (tau < 0) x = kt[(1 * 32 - tau) * 256 + cp * 16 + c];
            else { x = kt[cp * 16 + c] + kt[32 * 256 + cp * 16 + c]; if (c == cp) x += dsk[g * 16 + cp]; }
            v[i] = x; }
        u32x4 w; w.x = cvtpk(v[0], v[1]); w.y = cvtpk(v[2], v[3]); w.z = cvtpk(v[4], v[5]); w.w = cvtpk(v[6], v[7]);
        *(u32x4*)(mgt + (size_t)n * KY + kc * 8) = w;
    }
    for (int idx = tid; idx < 512 * 32; idx += 512) {
        const int n = idx >> 5, pc = idx & 31, tp = n >> 4, cp = n & 15, kq = pc * 8, dr = kq >> 7, reim = (kq >> 6) & 1, p0 = kq & 63;
        const int te = dr ? (32 - tp) : (tp + 1);
        float v[8];
#pragma unroll
        for (int i = 0; i < 8; ++i) { const int p = p0 + i;
            const float cr = c_re[((dr * S5G + g) * S5C + cp) * S5P + p], ci = c_im[((dr * S5G + g) * S5C + cp) * S5P + p];
            const float pr = apw[((dr * 33 + te) * 64 + p) * 2], pim = apw[((dr * 33 + te) * 64 + p) * 2 + 1];
            v[i] = reim ? -(cr * pim + ci * pr) : (cr * pr - ci * pim); }
        u32x4 w; w.x = cvtpk(v[0], v[1]); w.y = cvtpk(v[2], v[3]); w.z = cvtpk(v[4], v[5]); w.w = cvtpk(v[6], v[7]);
        *(u32x4*)(mgt + (size_t)n * KY + 512 + kq) = w;
    }
    for (int idx = tid; idx < 256 * 64; idx += 512) {
        const int n = idx >> 6, kc = idx & 63, dr = n >> 7, reim = (n >> 6) & 1, p = n & 63, t = kc >> 1, c0 = (kc & 1) * 8;
        const int te = dr ? t : (31 - t);
        const float pr = apw[((dr * 33 + te) * 64 + p) * 2], pim = apw[((dr * 33 + te) * 64 + p) * 2 + 1];
        const float kr = coef[(dr * 64 + p) * 2], ki = coef[(dr * 64 + p) * 2 + 1];
        float v[8];
#pragma unroll
        for (int i = 0; i < 8; ++i) { const int c = c0 + i;
            const float br = b_re[((dr * S5G + g) * S5P + p) * S5C + c], bi = b_im[((dr * S5G + g) * S5P + p) * S5C + c];
            const float btr = kr * br - ki * bi, bti = kr * bi + ki * br;
            v[i] = reim ? (pr * bti + pim * btr) : (pr * btr - pim * bti); }
        u32x4 w; w.x = cvtpk(v[0], v[1]); w.y = cvtpk(v[2], v[3]); w.z = cvtpk(v[4], v[5]); w.w = cvtpk(v[6], v[7]);
        *(u32x4*)(wst + (size_t)n * 512 + kc * 8) = w;
    }
    __syncthreads();
}

#ifndef PHASE_MASK
#define PHASE_MASK 0xFFFF
#endif
#define PH(k) if constexpr ((PHASE_MASK >> (k)) & 1)
constexpr int LDS_BYTES = 135168;
__global__ void __launch_bounds__(512, 2) fwd_megakernel(Params P) {
    extern __shared__ __attribute__((aligned(16))) unsigned char lds_raw[];
    LAS unsigned char* lds = (LAS unsigned char*)lds_raw;
    cg::grid_group grid = cg::this_grid();
    const int tid = threadIdx.x, lane = tid & 63, wave = __builtin_amdgcn_readfirstlane(tid >> 6);
    const int G = gridDim.x, bx = blockIdx.x;
    const int vcu = (G % 8 == 0) ? (bx % 8) * (G / 8) + bx / 8 : bx;
    unsigned char* ws = P.ws;
    const float* x = P.in[0];
#define XB ((bf16_t*)(ws + WS_XB))
#define RSTD1 ((float*)(ws + WS_RSTD1))
#define WIN ((bf16_t*)(ws + WS_WIN))
#define WGLU ((bf16_t*)(ws + WS_WGLU))
#define WAO ((bf16_t*)(ws + WS_WAO))
#define WWO ((bf16_t*)(ws + WS_WWO))
#define WF1 ((bf16_t*)(ws + WS_WF1))
#define WF2 ((bf16_t*)(ws + WS_WF2))
#define QO ((bf16_t*)(ws + WS_QO))
#define KIMG ((bf16_t*)(ws + WS_KIMG))
#define VIMG ((bf16_t*)(ws + WS_VIMG))
#define KMETA ((bf16_t*)(ws + WS_KMETA))
#define VMETA ((bf16_t*)(ws + WS_VMETA))
#define G1 ((bf16_t*)(ws + WS_G1))
#define G2 ((bf16_t*)(ws + WS_G2))
#define MGT ((bf16_t*)(ws + WS_MGT))
#define UGS ((bf16_t*)(ws + WS_UGS))
#define WSTT ((bf16_t*)(ws + WS_WSTT))
#define SLOC ((float*)(ws + WS_SLOC))
#define GY ((bf16_t*)(ws + WS_GY))
#define H1B ((bf16_t*)(ws + WS_H1B))
#define HBUF ((bf16_t*)(ws + WS_HBUF))
#define SS ((float*)(ws + WS_SS))
#define LUT ((float*)(ws + WS_LUT))
#define UMETA ((float*)(ws + WS_UMETA))

    PH(0) {
        if (bx < S5G) s5_prep_group(P, bx, lds);
        if (bx == S5G) {
            const float* tab = P.in[2];
            for (int idx = tid; idx < NH * NLUT; idx += 512) { const int h = idx / NLUT, rel = idx % NLUT - 91; LUT[idx] = tab[rel_bucket(rel) * NH + h] * LOG2E; }
            if (wave == 0) { const float a = wave_sum(P.in[17][lane] * P.in[18][lane]), c = wave_sum(P.in[19][lane] * P.in[20][lane]);
                if (lane == 0) LUT[NH * NLUT] = expf(a) - expf(c) + 0.2f; }
        }
        LAS float* scr = (LAS float*)(lds + wave * 8704);
        const int gw = vcu * 8 + wave, NGW = G * 8;
        constexpr int I0 = 16 * 144, I1 = 16 * 32, I2 = 8 * 64, I3 = 16 * 32, I4 = 16 * 32, I5 = 16 * 128, I6 = 64 * 32;
        constexpr int NITEMS = I0 + I1 + I2 + I3 + I4 + I5 + I6;
        for (int it = gw; it < NITEMS; it += NGW) {
            int r = it;
            if (r < I0) { const int kb = r / 144, nb = r % 144, n0 = 32 * nb, pn = n0 >> 8, rho = n0 & 255; const int mc = 256 * pn + 64 * ((rho >> 5) & 3) + 32 * (rho >> 7);
                tr_item(P.in[4], 5632, mc < 2560 ? mc : mc + 1024, 64 * kb, WIN, 1024, n0, P.in[3], 1023, 1.0f, scr, lane); continue; } r -= I0;
            if (r < I1) { const int kb = r / 32, nb = r % 32; tr_item(P.in[4], 5632, 2560 + 32 * nb, 64 * kb, WIN + (size_t)4608 * 1024, 1024, 32 * nb, P.in[3], 1023, 1.0f, scr, lane); continue; } r -= I1;
            if (r < I2) { const int kb = r / 64, nb = r % 64, n0 = 32 * nb, pn = n0 >> 8, rho = n0 & 255;
                tr_item((rho >> 7) ? P.in[14] : P.in[13], 1024, 128 * pn + (rho & 127), 64 * kb, WGLU, 512, n0, nullptr, 0, 1.0f, scr, lane); continue; } r -= I2;
            if (r < I3) { const int kb = r / 32, nb = r % 32; tr_item(P.in[22], 1024, 32 * nb, 64 * kb, WAO, 1024, 32 * nb, P.in[21], 127, 0.8f, scr, lane); continue; } r -= I3;
            if (r < I4) { const int kb = r / 32, nb = r % 32; tr_item(P.in[23], 1024, 32 * nb, 64 * kb, WWO, 1024, 32 * nb, nullptr, 0, 1.0f, scr, lane); continue; } r -= I4;
            if (r < I5) { const int kb = r / 128, nb = r % 128; tr_item(P.in[25], 4096, 32 * nb, 64 * kb, WF1, 1024, 32 * nb, P.in[24], 1023, 1.0f, scr, lane); continue; } r -= I5;
            { const int kb = r / 32, nb = r % 32; tr_item(P.in[26], 1024, 32 * nb, 64 * kb, WF2, 4096, 32 * nb, nullptr, 0, 1.0f, scr, lane); }
        }
        for (int r = gw; r < MPAD; r += NGW) {
            f32x4 v[4]; float s = 0.f;
            if (r < MTOK + NMETA) { const f32x4* xr = (const f32x4*)((r < MTOK) ? x + (size_t)r * D : P.in[1] + (size_t)(r - MTOK) * D) + lane;
#pragma unroll
                for (int j = 0; j < 4; ++j) { v[j] = xr[64 * j]; s += (v[j][0] * v[j][0] + v[j][1] * v[j][1]) + (v[j][2] * v[j][2] + v[j][3] * v[j][3]); }
            } else {
#pragma unroll
                for (int j = 0; j < 4; ++j) v[j] = (f32x4){0.f, 0.f, 0.f, 0.f};
            }
            s = wave_sum(s);
            if (lane == 0) RSTD1[r] = rsqrtf(s * (1.0f / D) + EPS);
            u32x2* o8 = (u32x2*)(XB + (size_t)r * D) + lane;
#pragma unroll
            for (int j = 0; j < 4; ++j) { u32x2 w; w.x = cvtpk(v[j][0], v[j][1]); w.y = cvtpk(v[j][2], v[j][3]); o8[64 * j] = w; }
        }
    }
    grid.sync();

    PH(1) {
        pg8::Gemm g{XB, WIN, 1024, 1024, 1024}; pg8::StaticOrder S; S.init(MPAD / 256, 18, G, bx);
        EpiInMain E{RSTD1, UGS, UMETA, QO, KIMG, KMETA, G1, G2, P.in[15], P.in[16]};
        pg8::gemm_phase<EpiInMain, pg8::StaticOrder, false>(lds, g, S, E);
    }
    PH(11) {
        pg8::Gemm g{XB, WIN + (size_t)4608 * 1024, 1024, 1024, 1024}; pg8::StaticOrder S; S.init(MPAD / 256, 4, G, bx);
        EpiInV E{RSTD1, VIMG, VMETA};
        pg8::gemm_phase<EpiInV, pg8::StaticOrder, true>(lds, g, S, E);
    }
    grid.sync();

    PH(2) {
        pg8::Gemm g{UGS, WSTT, KY, 512, 512}; pg8::GroupOrder<4, 1> S{G, bx};
        EpiSloc E{SLOC};
        pg8::gemm_phase<EpiSloc, pg8::GroupOrder<4, 1>, false>(lds, g, S, E);
    }
    grid.sync();

    PH(3) {
        const int gid = bx * 512 + tid;
        if (gid < S5G * BATCH * 2 * S5P) {
            const int p = gid & 63, dr = (gid >> 6) & 1, b = (gid >> 7) & 7, g = gid >> 10;
            const float dt = expf(P.in[7][dr * S5G + g]); const float lr = P.in[5][(dr * S5G + g) * S5P + p], li = P.in[6][(dr * S5G + g) * S5P + p];
            float sn, cs; sincosf(li * dt, &sn, &cs); const float mg = expf(lr * dt); const float a1r = mg * cs, a1i = mg * sn;
            sincosf(li * dt * 32.0f, &sn, &cs); const float mg32 = expf(lr * dt * 32.0f); const float ar = mg32 * cs, ai = mg32 * sn;
            float sr = 0.f, si = 0.f;
            if (dr == 0) {
                const float den = lr * lr + li * li; const float kr = ((a1r - 1.0f) * lr + a1i * li) / den, ki = (a1i * lr - (a1r - 1.0f) * li) / den;
                float btr[16], bti[16];
#pragma unroll
                for (int c = 0; c < 16; ++c) { const float br = P.in[8][((size_t)g * S5P + p) * S5C + c], bi = P.in[9][((size_t)g * S5P + p) * S5C + c]; btr[c] = kr * br - ki * bi; bti[c] = kr * bi + ki * br; }
                for (int m = 0; m < NMETA; ++m) { float xr = 0.f, xi = 0.f;
#pragma unroll
                    for (int c = 0; c < 16; ++c) { const float uv = UMETA[m * S5W + g * 16 + c]; xr += btr[c] * uv; xi += bti[c] * uv; }
                    const float nr = a1r * sr - a1i * si + xr, ni = a1r * si + a1i * sr + xi; sr = nr; si = ni; }
            }
            const size_t rbase = (size_t)g * 1024 + b * 128;
            const float* sl = SLOC + rbase * 256 + dr * 128 + p; bf16_t* so = UGS + rbase * KY + 512 + dr * 128 + p;
#pragma unroll 8
            for (int i = 0; i < NCH; ++i) { const int ch = dr ? (NCH - 1 - i) : i;
                const float lr_ = sl[(size_t)ch * 256], li_ = sl[(size_t)ch * 256 + 64];
                so[(size_t)ch * KY] = (bf16_t)(cvtpk(sr, sr) & 0xffffu); so[(size_t)ch * KY + 64] = (bf16_t)(cvtpk(si, si) & 0xffffu);
                const float nr = ar * sr - ai * si + lr_, ni = ar * si + ai * sr + li_; sr = nr; si = ni; }
        }
    }
    grid.sync();

    PH(4) {
        pg8::Gemm g{UGS, MGT, KY, KY, KY}; pg8::GroupOrder<4, 2> S{G, bx};
        EpiY E{GY};
        pg8::gemm_phase<EpiY, pg8::GroupOrder<4, 2>, false>(lds, g, S, E);
    }
    grid.sync();

    PH(5) {
        pg8::Gemm g{GY, WGLU, 512, 512, 512}; pg8::StaticOrder S; S.init(MTOK / 256, 8, G, bx);
        EpiGlu E{G1};
        pg8::gemm_phase<EpiGlu, pg8::StaticOrder, false>(lds, g, S, E);
    }
    PH(6) {
        const int nunits = BATCH * NH * (SEQ / 128);
        for (int i = 0; ; ++i) {
            int bh, qb;
            if (G == 256) { if (i >= 8) break; bh = (vcu >> 5) * 8 + i; qb = vcu & 31; }
            else { const int U = i * G + bx; if (U >= nunits) break; bh = U >> 5; qb = U & 31; }
            attn_unit(lds, bh, qb, QO, KIMG, VIMG, KMETA, VMETA, LUT);
        }
    }
    grid.sync();

    PH(7) {
        pg8::Gemm g{QO, WAO, 1024, 1024, 1024}; pg8::StaticOrder S; S.init(MTOK / 256, 4, G, bx);
        EpiAo E{G1, G2};
        pg8::gemm_phase<EpiAo, pg8::StaticOrder, false>(lds, g, S, E);
    }
    grid.sync();

    PH(8) {
        pg8::Gemm g{G2, WWO, 1024, 1024, 1024}; pg8::StaticOrder S; S.init(MTOK / 256, 4, G, bx);
        EpiWo E{x, P.out, H1B, SS};
        pg8::gemm_phase<EpiWo, pg8::StaticOrder, false>(lds, g, S, E);
    }
    grid.sync();

    PH(9) {
        pg8::Gemm g{H1B, WF1, 1024, 1024, 1024}; pg8::StaticOrder S; S.init(MTOK / 256, 16, G, bx);
        EpiF1 E{SS, HBUF};
        pg8::gemm_phase<EpiF1, pg8::StaticOrder, false>(lds, g, S, E);
    }
    grid.sync();

    PH(10) {
        pg8::Gemm g{HBUF, WF2, 4096, 4096, 4096}; pg8::StaticOrder S; S.init(MTOK / 256, 4, G, bx);
        EpiF2 E{P.out};
        pg8::gemm_phase<EpiF2, pg8::StaticOrder, false>(lds, g, S, E);
    }
}

extern "C" void kernel_launch(void* const* d_in, const int* in_sizes, int n_in, void* d_out, int out_size, void* d_ws, size_t ws_size, hipStream_t stream) {
    static int grid = 0;
    if (grid == 0) {
        if (n_in != 27 || ws_size < WS_END) { fprintf(stderr, "kernel_launch: unexpected inputs (n_in %d, ws %zu)\n", n_in, ws_size); grid = -1; return; }
        int dev = 0, cus = 0, per_cu = 0;
        hipGetDevice(&dev); hipDeviceGetAttribute(&cus, hipDeviceAttributeMultiprocessorCount, dev);
        hipFuncSetAttribute((const void*)fwd_megakernel, hipFuncAttributeMaxDynamicSharedMemorySize, LDS_BYTES);
        if (hipOccupancyMaxActiveBlocksPerMultiprocessor(&per_cu, (const void*)fwd_megakernel, 512, LDS_BYTES) != hipSuccess || per_cu < 1) per_cu = 1;
        (void)hipGetLastError();
        grid = cus * 1;
        if (grid <= 0) grid = 256;
    }
    if (grid < 0) return;
    Params p{};
    for (int i = 0; i < 27; ++i) p.in[i] = (const float*)d_in[i];
    p.out = (float*)d_out; p.ws = (unsigned char*)d_ws;
    void* args[] = {&p};
    hipError_t e = hipLaunchCooperativeKernel((const void*)fwd_megakernel, dim3(grid), dim3(512), args, LDS_BYTES, stream);
    if (e != hipSuccess) fprintf(stderr, "cooperative launch failed: %s (grid %d)\n", hipGetErrorString(e), grid);
}
```

```cpp
#include <hip/hip_runtime.h>
#include <hip/hip_cooperative_groups.h>
#include <cstdio>
#include <cstdint>
namespace cg = cooperative_groups;

#define LAS __attribute__((address_space(3)))
typedef unsigned short bf16_t;
typedef short bf16x8 __attribute__((ext_vector_type(8)));
typedef float f32x4 __attribute__((ext_vector_type(4)));
typedef float f32x16 __attribute__((ext_vector_type(16)));
typedef unsigned u32x4 __attribute__((ext_vector_type(4)));
typedef unsigned u32x2 __attribute__((ext_vector_type(2)));
typedef float f32x2_t __attribute__((ext_vector_type(2)));
typedef __bf16 bf16x2_t __attribute__((ext_vector_type(2)));

__device__ __forceinline__ unsigned cvtpk(float lo, float hi) { f32x2_t v = {lo, hi}; bf16x2_t b = __builtin_convertvector(v, bf16x2_t); return __builtin_bit_cast(unsigned, b); }
__device__ __forceinline__ float bf2f(unsigned short h) { return __uint_as_float(((unsigned)h) << 16); }
__device__ __forceinline__ float sigmoidf_(float x) { return 1.0f / (1.0f + __expf(-x)); }

constexpr int D = 1024, BATCH = 8, SEQ = 4096, NMETA = 16;
constexpr int MTOK = BATCH * SEQ;
constexpr int MPAD = MTOK + 256;
constexpr int S5W = 512, S5G = 32, S5C = 16, S5P = 64;
constexpr int NH = 8, HD = 64, VD = 128;
constexpr int DFF = 4096;
constexpr int TCH = 32, NCH = SEQ / TCH;
constexpr int KY = TCH * S5C + 4 * S5P;
constexpr float EPS = 1e-6f;
constexpr float LOG2E = 1.4426950408889634f;
constexpr float QSCALE = 0.125f * LOG2E;
constexpr int NLUT = 183;

constexpr size_t MiB = 1u << 20;
constexpr size_t WS_XB = 0;
constexpr size_t WS_SLOC = 0;
constexpr size_t WS_GY = 32 * MiB;
constexpr size_t WS_QO = 65 * MiB;
constexpr size_t WS_KIMG = 129 * MiB;
constexpr size_t WS_VIMG = 193 * MiB;
constexpr size_t WS_KMETA = 257 * MiB;
constexpr size_t WS_VMETA = 257 * MiB + 128 * 1024;
constexpr size_t WS_HBUF = 0;
constexpr size_t WS_G1 = 258 * MiB;
constexpr size_t WS_G2 = 322 * MiB;
constexpr size_t WS_MGT = 386 * MiB;
constexpr size_t WS_UGS = 410 * MiB;
constexpr size_t WS_WSTT = 458 * MiB;
constexpr size_t WS_H1B = 386 * MiB;
constexpr size_t WS_WIN = 466 * MiB;
constexpr size_t WS_WGLU = 477 * MiB;
constexpr size_t WS_WAO = 479 * MiB;
constexpr size_t WS_WWO = 481 * MiB;
constexpr size_t WS_WF1 = 483 * MiB;
constexpr size_t WS_WF2 = 491 * MiB;
constexpr size_t WS_RSTD1 = 499 * MiB;
constexpr size_t WS_SS = WS_RSTD1 + 256 * 1024;
constexpr size_t WS_LUT = WS_SS + 2 * MiB;
constexpr size_t WS_UMETA = WS_LUT + 8 * 1024;
constexpr size_t WS_CTL = WS_UMETA + 32 * 1024;
constexpr size_t CTL_BYTES = 32 * 1024;
constexpr size_t WS_END = WS_CTL + CTL_BYTES;

namespace pg8 {
constexpr int BM = 256, BK = 64, HALF = 128, HTB = HALF * BK * 2, STAGE_BYTES = 8 * HTB, NXCD = 8, WGM = 8;
__host__ __device__ __forceinline__ int lds_byte(int r, int c) { const int st = (r >> 4) * 2 + (c >> 5), rr = r & 15, cc = c & 31, ob = rr * 64 + cc * 2; return st * 1024 + (ob ^ (((ob >> 9) & 1) << 5)); }
__host__ __device__ __forceinline__ void stage_rc(int b, int& R, int& C) { const int st = b / 1024, sb = b % 1024, swz = sb ^ (((sb >> 9) & 1) << 5); R = (st >> 1) * 16 + swz / 64; C = (st & 1) * 32 + (swz % 64) / 2; }
__host__ __device__ __forceinline__ int perm32(int rho) { const int n = rho >> 4, i = rho & 15; return 8 * (i >> 2) + 4 * n + (i & 3); }

struct Unit { int pm, pn; };
struct Gemm { const bf16_t* A; const bf16_t* Bt; int lda, ldb, K; };

struct StaticOrder {
    int nM, nN, nwg, G, c;
    __device__ void init(int nM_, int nN_, int G_, int c_) { nM = nM_; nN = nN_; nwg = nM * nN; G = G_; c = c_; }
    __device__ bool next(int i, Unit& u) const {
        const long L = (long)i * G + c; if (L >= nwg) return false;
        int wgid = (int)L; { const int q = nwg / NXCD, r = nwg % NXCD, xcd = wgid % NXCD, off = wgid / NXCD; wgid = (xcd < r ? xcd * (q + 1) : r * (q + 1) + (xcd - r) * q) + off; }
        const int nig = WGM * nN, gid = wgid / nig, fm = gid * WGM, gsz = (nM - fm) < WGM ? (nM - fm) : WGM;
        u.pm = fm + ((wgid % nig) % gsz); u.pn = (wgid % nig) / gsz; return true;
    }
};
struct PanelOrder {
    int pm, nN, G, c;
    __device__ bool next(int i, Unit& u) const { const int L = i * G + c; if (L >= nN) return false; u.pm = pm; u.pn = L; return true; }
};
template <int RM, int CN> struct GroupOrder {
    int G, c;
    __device__ bool next(int i, Unit& u) const {
        const int L = i * G + c; if (L >= 32 * RM * CN) return false;
        const int g = L / (RM * CN), r = L % (RM * CN);
        u.pm = g * RM + r / CN; u.pn = g * CN + r % CN; return true;
    }
};

template <class Epi, class Sched, bool SWAP>
__device__ __forceinline__ void gemm_phase(LAS unsigned char* lds, const Gemm g, const Sched& S, const Epi& E) {
    const int tid = threadIdx.x, wid = __builtin_amdgcn_readfirstlane(tid >> 6), lane = tid & 63, wr = wid >> 2, wc = wid & 3, fr = lane & 15, fq = lane >> 4;
    const int K = g.K, nt = K / BK;
    unsigned voffA[2], voffB[2];
#pragma unroll
    for (int i = 0; i < 2; ++i) { int R, C; stage_rc(tid * 16 + i * 8192, R, C); const int Rb = Epi::PERM ? ((R & ~31) + perm32(R & 31)) : R;
        voffA[i] = (unsigned)(R * g.lda + C) * 2u; voffB[i] = (unsigned)(Rb * g.ldb + C) * 2u; }
    const size_t kstep = (size_t)(BK * 2);
    const size_t hstepA = (size_t)HALF * g.lda * 2, hstepB = (size_t)HALF * g.ldb * 2;
    const size_t tstepA = 2 * hstepA, tstepB = 2 * hstepB;
    const unsigned ldsw = (unsigned)wid * 1024u;
    const int aoff = lds_byte(wr * 64 + fr, fq * 8), boff = lds_byte(wc * 32 + fr, fq * 8);
#define PG8_SA(b, h) (((b) * 2 + (h)) * HTB)
#define PG8_SB(b, h) ((4 + (b) * 2 + (h)) * HTB)
#define PG8_STAGE(bufoff, gbase, voff) do { _Pragma("unroll") for (int _i = 0; _i < 2; ++_i) \
        __builtin_amdgcn_global_load_lds((const unsigned*)((const char*)(gbase) + (voff)[_i]), (LAS unsigned*)(lds + (bufoff) + ldsw + _i * 8192), 16, 0, 0); } while (0)
#define PG8_LDA(dst, b, h) do { _Pragma("unroll") for (int m = 0; m < 4; ++m) _Pragma("unroll") for (int k = 0; k < 2; ++k) dst[m][k] = *(const LAS bf16x8*)(lds + PG8_SA(b, h) + aoff + m * 2048 + k * 1024); } while (0)
#define PG8_LDB(dst, b, h) do { _Pragma("unroll") for (int n = 0; n < 2; ++n) _Pragma("unroll") for (int k = 0; k < 2; ++k) dst[n][k] = *(const LAS bf16x8*)(lds + PG8_SB(b, h) + boff + n * 2048 + k * 1024); } while (0)
#define PG8_MMA(ai, bj, At, Bt) do { __builtin_amdgcn_s_setprio(1); _Pragma("unroll") for (int m = 0; m < 4; ++m) _Pragma("unroll") for (int n = 0; n < 2; ++n) _Pragma("unroll") for (int k = 0; k < 2; ++k) \
        acc[ai][bj][m][n] = SWAP ? __builtin_amdgcn_mfma_f32_16x16x32_bf16(At[m][k], Bt[n][k], acc[ai][bj][m][n], 0, 0, 0) \
                                 : __builtin_amdgcn_mfma_f32_16x16x32_bf16(Bt[n][k], At[m][k], acc[ai][bj][m][n], 0, 0, 0); __builtin_amdgcn_s_setprio(0); } while (0)
#define PG8_WAIT_V(n) asm volatile("s_waitcnt vmcnt(" #n ")" ::: "memory")
#define PG8_WAIT_L(n) asm volatile("s_waitcnt lgkmcnt(" #n ")" ::: "memory")
#define PG8_BAR __builtin_amdgcn_s_barrier()
#define PG8_SCHED __builtin_amdgcn_sched_barrier(0)
    Unit cur, nxt; int ui = 0;
    if (!S.next(0, cur)) return;
    f32x4 acc[2][2][4][2];
#pragma unroll
    for (int a = 0; a < 2; ++a)
#pragma unroll
        for (int b = 0; b < 2; ++b)
#pragma unroll
            for (int m = 0; m < 4; ++m)
#pragma unroll
                for (int n = 0; n < 2; ++n) acc[a][b][m][n] = (f32x4){0.f, 0.f, 0.f, 0.f};
    bf16x8 At[4][2], B0[2][2], B1[2][2];
    const char* cA = (const char*)g.A + (size_t)cur.pm * tstepA; const char* cB = (const char*)g.Bt + (size_t)cur.pn * tstepB;
    PG8_STAGE(PG8_SB(0, 0), cB, voffB); PG8_STAGE(PG8_SB(0, 1), cB + hstepB, voffB); PG8_STAGE(PG8_SA(0, 0), cA, voffA); PG8_STAGE(PG8_SA(0, 1), cA + hstepA, voffA);
    if (wr == 1) PG8_BAR;
    PG8_WAIT_V(2); PG8_BAR;
    PG8_STAGE(PG8_SB(1, 0), cB + kstep, voffB); PG8_STAGE(PG8_SA(1, 0), cA + kstep, voffA); PG8_STAGE(PG8_SB(1, 1), cB + hstepB + kstep, voffB);
    PG8_WAIT_V(6); PG8_BAR;
    for (;;) {
        const bool has_next = S.next(ui + 1, nxt);
        const char* nA = has_next ? (const char*)g.A + (size_t)nxt.pm * tstepA : cA; const char* nB = has_next ? (const char*)g.Bt + (size_t)nxt.pn * tstepB : cB;
        for (int t = 0; t < nt; t += 2) {
            const bool last = (t == nt - 2);
            const char* a1 = cA + (size_t)(t + 1) * kstep;
            const char* a2 = last ? nA : cA + (size_t)(t + 2) * kstep; const char* b2 = last ? nB : cB + (size_t)(t + 2) * kstep;
            const char* a3 = a2 + kstep; const char* b3 = b2 + kstep;
            PG8_LDB(B0, 0, 0); PG8_LDB(B1, 0, 1); PG8_SCHED; PG8_LDA(At, 0, 0); PG8_STAGE(PG8_SA(1, 1), a1 + hstepA, voffA);
            PG8_WAIT_V(8); PG8_WAIT_L(0); PG8_BAR; PG8_MMA(0, 0, At, B0); PG8_MMA(0, 1, At, B1); PG8_BAR; PG8_SCHED;
            PG8_LDA(At, 0, 1); PG8_STAGE(PG8_SB(0, 0), b2, voffB); PG8_STAGE(PG8_SB(0, 1), b2 + hstepB, voffB); PG8_STAGE(PG8_SA(0, 0), a2, voffA);
            PG8_WAIT_V(8); PG8_WAIT_L(0); PG8_BAR; PG8_MMA(1, 0, At, B0); PG8_MMA(1, 1, At, B1); PG8_BAR; PG8_SCHED;
            PG8_LDB(B0, 1, 0); PG8_LDB(B1, 1, 1); PG8_SCHED; PG8_LDA(At, 1, 0); PG8_STAGE(PG8_SA(0, 1), a2 + hstepA, voffA);
            PG8_WAIT_V(8); PG8_WAIT_L(0); PG8_BAR; PG8_MMA(0, 0, At, B0); PG8_MMA(0, 1, At, B1); PG8_BAR; PG8_SCHED;
            PG8_LDA(At, 1, 1); PG8_STAGE(PG8_SB(1, 0), b3, voffB); PG8_STAGE(PG8_SB(1, 1), b3 + hstepB, voffB); PG8_STAGE(PG8_SA(1, 0), a3, voffA);
            PG8_WAIT_V(8); PG8_WAIT_L(0); PG8_BAR; PG8_MMA(1, 0, At, B0); PG8_MMA(1, 1, At, B1); PG8_BAR; PG8_SCHED;
        }
        if (wr == 0) PG8_BAR;
        { int le = lane; asm volatile("" : "+v"(le)); E(acc, cur, wr, wc, le & 15, le >> 4); }
        if (!has_next) break;
#pragma unroll
        for (int a = 0; a < 2; ++a)
#pragma unroll
            for (int b = 0; b < 2; ++b)
#pragma unroll
                for (int m = 0; m < 4; ++m)
#pragma unroll
                    for (int n = 0; n < 2; ++n) acc[a][b][m][n] = (f32x4){0.f, 0.f, 0.f, 0.f};
        cur = nxt; cA = nA; cB = nB; ++ui;
        if (wr == 1) PG8_BAR;
    }
    PG8_WAIT_V(0);
    PG8_BAR;
#undef PG8_SA
#undef PG8_SB
#undef PG8_STAGE
#undef PG8_LDA
#undef PG8_LDB
#undef PG8_MMA
#undef PG8_WAIT_V
#undef PG8_WAIT_L
#undef PG8_BAR
#undef PG8_SCHED
}
}
using pg8::Unit;

__device__ __forceinline__ int pi_slot(int k) { return (k & ~12) | ((k & 4) << 1) | ((k & 8) >> 1); }
__device__ __forceinline__ u32x4 pack8(const f32x4 a, const f32x4 b) { u32x4 w; w.x = cvtpk(a[0], a[1]); w.y = cvtpk(a[2], a[3]); w.z = cvtpk(b[0], b[1]); w.w = cvtpk(b[2], b[3]); return w; }

__device__ __forceinline__ float bflo(unsigned w) { return __uint_as_float(w << 16); }
__device__ __forceinline__ float bfhi(unsigned w) { return __uint_as_float(w & 0xffff0000u); }
struct EpiInMain {
    static constexpr bool PERM = true;
    const float* rstd1; bf16_t* ugs; float* umeta; bf16_t* qbuf; bf16_t* kimg; bf16_t* kmeta; bf16_t* g1; bf16_t* g2; const float* qn; const float* kn;
    __device__ __forceinline__ void operator()(const f32x4 (&acc)[2][2][4][2], const Unit& u, int wr, int wc, int fr, int fq) const {
        const int pn = u.pn, pm = u.pm; const bool meta = (pm == MTOK / 256);
        const int b = pm >> 4;
        float rsv[2][4];
#pragma unroll
        for (int ai = 0; ai < 2; ++ai)
#pragma unroll
            for (int m = 0; m < 4; ++m) rsv[ai][m] = rstd1[pm * 256 + ai * 128 + wr * 64 + m * 16 + fr];
        f32x4 gw[2][2];
        { const float* gp = (pn < 6) ? qn : kn; const float sc = (pn < 6) ? QSCALE : 1.0f;
#pragma unroll
          for (int bj = 0; bj < 2; ++bj)
#pragma unroll
              for (int n = 0; n < 2; ++n) gw[bj][n] = (pn >= 2 && pn < 10) ? *(const f32x4*)(gp + 32 * bj + 8 * fq + 4 * n) * sc : (f32x4){1.f, 1.f, 1.f, 1.f}; }
#pragma unroll
        for (int ai = 0; ai < 2; ++ai)
#pragma unroll
            for (int m = 0; m < 4; ++m) {
                const int rloc = ai * 128 + wr * 64 + m * 16 + fr;
                const int r = pm * 256 + rloc;
                const int j = (pm & 15) * 256 + rloc;
                const float rs = rsv[ai][m];
                f32x4 v[2][2];
#pragma unroll
                for (int bj = 0; bj < 2; ++bj)
#pragma unroll
                    for (int n = 0; n < 2; ++n) v[bj][n] = acc[ai][bj][m][n] * rs;
                if (pn < 2) {
#pragma unroll
                    for (int bj = 0; bj < 2; ++bj) {
                        const int c = 256 * pn + 64 * wc + 32 * bj + 8 * fq;
                        if (!meta) { const int gg = c >> 4, c0 = c & 15;
                            bf16_t* dst = ugs + ((size_t)gg * (BATCH * NCH) + b * NCH + (j >> 5)) * KY + (j & 31) * 16 + c0;
                            *(u32x4*)dst = pack8(v[bj][0], v[bj][1]);
                        } else if (rloc < NMETA) { float* dst = umeta + rloc * S5W + c; *(f32x4*)dst = v[bj][0]; *(f32x4*)(dst + 4) = v[bj][1]; }
                    }
                } else if (pn < 10) {
                    float ss = 0.f;
#pragma unroll
                    for (int bj = 0; bj < 2; ++bj)
#pragma unroll
                        for (int n = 0; n < 2; ++n) { const f32x4 x = v[bj][n]; ss += (x[0] * x[0] + x[1] * x[1]) + (x[2] * x[2] + x[3] * x[3]); }
                    ss += __shfl_xor(ss, 16); ss += __shfl_xor(ss, 32);
                    const float sc = rsqrtf(ss * (1.0f / 64.0f) + EPS);
#pragma unroll
                    for (int bj = 0; bj < 2; ++bj) {
                        const f32x4 o0 = v[bj][0] * gw[bj][0] * sc, o1 = v[bj][1] * gw[bj][1] * sc;
                        const u32x4 w = pack8(o0, o1);
                        if (pn < 6) { if (!meta) { const int cq = 256 * (pn - 2) + 64 * wc + 32 * bj + 8 * fq; *(u32x4*)(qbuf + (size_t)r * 1024 + cq) = w; } }
                        else { const int h = 2 * (pn - 6) + (wc >> 1), chunk = 8 * (wc & 1) + 4 * bj + fq;
                            if (!meta) { const int tile = j >> 6, slot = pi_slot(j & 63);
                                *(u32x4*)(kimg + ((((size_t)(b * NH + h) * 64 + tile) * 16 + chunk) * 64 + slot) * 8) = w;
                            } else if (rloc < 64) { *(u32x4*)(kmeta + (((size_t)h * 16 + chunk) * 64 + pi_slot(rloc)) * 8) = w; } }
                    }
                } else {
                    if (!meta) { bf16_t* gb = (pn < 14) ? g1 : g2; const int pg = (pn < 14) ? pn - 10 : pn - 14;
#pragma unroll
                        for (int bj = 0; bj < 2; ++bj) { f32x4 o0, o1;
#pragma unroll
                            for (int i = 0; i < 4; ++i) { o0[i] = sigmoidf_(v[bj][0][i]); o1[i] = sigmoidf_(v[bj][1][i]); }
                            *(u32x4*)(gb + (size_t)r * 1024 + 256 * pg + 64 * wc + 32 * bj + 8 * fq) = pack8(o0, o1); } }
                }
            }
    }
};
struct EpiInV {
    static constexpr bool PERM = false;
    const float* rstd1; bf16_t* vimg; bf16_t* vmeta;
    __device__ __forceinline__ void operator()(const f32x4 (&acc)[2][2][4][2], const Unit& u, int wr, int wc, int fr, int fq) const {
        const int pn = u.pn, pm = u.pm; const bool meta = (pm == MTOK / 256); const int b = pm >> 4;
        f32x4 rsv[2][4];
#pragma unroll
        for (int ai = 0; ai < 2; ++ai)
#pragma unroll
            for (int m = 0; m < 4; ++m) rsv[ai][m] = *(const f32x4*)(rstd1 + pm * 256 + ai * 128 + wr * 64 + m * 16 + 4 * fq);
#pragma unroll
        for (int ai = 0; ai < 2; ++ai) {
            if (meta && (ai | wr)) continue;
            const int tile = (pm & 15) * 4 + 2 * ai + wr;
#pragma unroll
            for (int m = 0; m < 4; ++m) {
                const f32x4 rs = rsv[ai][m];
                const int kvchunk = 2 * m + (fq >> 1), within = 4 * (fq & 1);
#pragma unroll
                for (int bj = 0; bj < 2; ++bj)
#pragma unroll
                    for (int n = 0; n < 2; ++n) {
                        const int h = 2 * pn + bj, e = 32 * wc + 16 * n + fr;
                        const f32x4 x = acc[ai][bj][m][n] * rs;
                        u32x2 w; w.x = cvtpk(x[0], x[1]); w.y = cvtpk(x[2], x[3]);
                        bf16_t* dst = meta ? vmeta + (((size_t)h * 8 + kvchunk) * 128 + e) * 8 + within
                                           : vimg + ((((size_t)(b * NH + h) * 64 + tile) * 8 + kvchunk) * 128 + e) * 8 + within;
                        *(u32x2*)dst = w;
                    }
            }
        }
    }
};
struct EpiSloc {
    static constexpr bool PERM = true;
    float* sloc;
    __device__ __forceinline__ void operator()(const f32x4 (&acc)[2][2][4][2], const Unit& u, int wr, int wc, int fr, int fq) const {
#pragma unroll
        for (int ai = 0; ai < 2; ++ai)
#pragma unroll
            for (int m = 0; m < 4; ++m) { const int r = u.pm * 256 + ai * 128 + wr * 64 + m * 16 + fr;
#pragma unroll
                for (int bj = 0; bj < 2; ++bj) { float* dst = sloc + (size_t)r * 256 + 128 * bj + 32 * wc + 8 * fq;
                    *(f32x4*)dst = acc[ai][bj][m][0]; *(f32x4*)(dst + 4) = acc[ai][bj][m][1]; } }
    }
};
__device__ __forceinline__ float gelu_tanh(float x) { const float u = 0.7978845608028654f * (x + 0.044715f * x * x * x); return x / (1.0f + __expf(-2.0f * u)); }
struct EpiY {
    static constexpr bool PERM = true;
    bf16_t* gy;
    __device__ __forceinline__ void operator()(const f32x4 (&acc)[2][2][4][2], const Unit& u, int wr, int wc, int fr, int fq) const {
        const int g = u.pm >> 2;
#pragma unroll
        for (int ai = 0; ai < 2; ++ai)
#pragma unroll
            for (int m = 0; m < 4; ++m) { const int rg = (u.pm & 3) * 256 + ai * 128 + wr * 64 + m * 16 + fr;
                const int b = rg >> 7, ch = rg & 127;
#pragma unroll
                for (int bj = 0; bj < 2; ++bj) { const int n0 = 256 * (u.pn & 1) + 128 * bj + 32 * wc + 8 * fq; const int tp = n0 >> 4, c0 = n0 & 15;
                    f32x4 o0, o1;
#pragma unroll
                    for (int i = 0; i < 4; ++i) { o0[i] = gelu_tanh(acc[ai][bj][m][0][i]); o1[i] = gelu_tanh(acc[ai][bj][m][1][i]); }
                    *(u32x4*)(gy + ((size_t)b * SEQ + ch * TCH + tp) * S5W + g * 16 + c0) = pack8(o0, o1); } }
    }
};
struct EpiGlu {
    static constexpr bool PERM = true;
    bf16_t* g1; int dry;
    __device__ __forceinline__ void operator()(const f32x4 (&acc)[2][2][4][2], const Unit& u, int wr, int wc, int fr, int fq) const {
        u32x4 gv[2][4];
#pragma unroll
        for (int ai = 0; ai < 2; ++ai)
#pragma unroll
            for (int m = 0; m < 4; ++m) gv[ai][m] = *(const u32x4*)(g1 + (size_t)(u.pm * 256 + ai * 128 + wr * 64 + m * 16 + fr) * 1024 + 128 * u.pn + 32 * wc + 8 * fq);
#pragma unroll
        for (int ai = 0; ai < 2; ++ai)
#pragma unroll
            for (int m = 0; m < 4; ++m) { const int r = u.pm * 256 + ai * 128 + wr * 64 + m * 16 + fr;
                bf16_t* p = g1 + (size_t)r * 1024 + 128 * u.pn + 32 * wc + 8 * fq;
                const u32x4 g = gv[ai][m]; f32x4 o0, o1;
#pragma unroll
                for (int i = 0; i < 4; ++i) {
                    const float ga = (i & 1) ? bfhi(g[i >> 1]) : bflo(g[i >> 1]), gb = (i & 1) ? bfhi(g[2 + (i >> 1)]) : bflo(g[2 + (i >> 1)]);
                    o0[i] = acc[ai][0][m][0][i] * sigmoidf_(acc[ai][1][m][0][i]) * ga;
                    o1[i] = acc[ai][0][m][1][i] * sigmoidf_(acc[ai][1][m][1][i]) * gb; }
                if (!dry) *(u32x4*)p = pack8(o0, o1); }
    }
};
struct EpiAo {
    static constexpr bool PERM = true;
    const bf16_t* t2; bf16_t* g2; int dry;
    __device__ __forceinline__ void operator()(const f32x4 (&acc)[2][2][4][2], const Unit& u, int wr, int wc, int fr, int fq) const {
        u32x4 gv[2][2][2], tv[2][2][2];
#define AO_OFF(q, mm, bj) ((size_t)(u.pm * 256 + ((q) >> 1) * 128 + wr * 64 + (((q) & 1) * 2 + (mm)) * 16 + fr) * 1024 + 256 * u.pn + 128 * (bj) + 32 * wc + 8 * fq)
#define AO_LOAD(buf, q) do { _Pragma("unroll") for (int mm = 0; mm < 2; ++mm) _Pragma("unroll") for (int bj = 0; bj < 2; ++bj) { \
            gv[buf][mm][bj] = *(const u32x4*)(g2 + AO_OFF(q, mm, bj)); tv[buf][mm][bj] = *(const u32x4*)(t2 + AO_OFF(q, mm, bj)); } } while (0)
        AO_LOAD(0, 0);
#pragma unroll
        for (int q = 0; q < 4; ++q) {
            if (q + 1 < 4) { if (q & 1) AO_LOAD(0, q + 1); else AO_LOAD(1, q + 1); }
#pragma unroll
            for (int mm = 0; mm < 2; ++mm)
#pragma unroll
                for (int bj = 0; bj < 2; ++bj) { const u32x4 g = gv[q & 1][mm][bj], t = tv[q & 1][mm][bj]; const int ai = q >> 1, m = (q & 1) * 2 + mm; f32x4 o0, o1;
#pragma unroll
                    for (int i = 0; i < 4; ++i) {
                        const float ga = (i & 1) ? bfhi(g[i >> 1]) : bflo(g[i >> 1]), gb = (i & 1) ? bfhi(g[2 + (i >> 1)]) : bflo(g[2 + (i >> 1)]);
                        const float ta = (i & 1) ? bfhi(t[i >> 1]) : bflo(t[i >> 1]), tb = (i & 1) ? bfhi(t[2 + (i >> 1)]) : bflo(t[2 + (i >> 1)]);
                        o0[i] = ta + ga * acc[ai][bj][m][0][i]; o1[i] = tb + gb * acc[ai][bj][m][1][i]; }
                    if (!dry) *(u32x4*)(g2 + AO_OFF(q, mm, bj)) = pack8(o0, o1); }
        }
#undef AO_LOAD
#undef AO_OFF
    }
};
struct EpiWo {
    static constexpr bool PERM = false;
    const float* x; float* out; bf16_t* h1b; float* ss; int dry;
    __device__ __forceinline__ void operator()(const f32x4 (&acc)[2][2][4][2], const Unit& u, int wr, int wc, int fr, int fq) const {
        f32x4 xv[2][2][2][2];
#define WO_OFF(q, mm, bj, n) ((size_t)(u.pm * 256 + ((q) >> 1) * 128 + wr * 64 + (((q) & 1) * 2 + (mm)) * 16 + fr) * 1024 + 256 * u.pn + 128 * (bj) + 32 * wc + 16 * (n) + 4 * fq)
#define WO_LOAD(buf, q) do { _Pragma("unroll") for (int mm = 0; mm < 2; ++mm) _Pragma("unroll") for (int bj = 0; bj < 2; ++bj) _Pragma("unroll") for (int n = 0; n < 2; ++n) \
            xv[buf][mm][bj][n] = *(const f32x4*)(x + WO_OFF(q, mm, bj, n)); } while (0)
        WO_LOAD(0, 0);
#pragma unroll
        for (int q = 0; q < 4; ++q) {
            if (q + 1 < 4) { if (q & 1) WO_LOAD(0, q + 1); else WO_LOAD(1, q + 1); }
#pragma unroll
            for (int mm = 0; mm < 2; ++mm) { const int ai = q >> 1, m = (q & 1) * 2 + mm; const int r = u.pm * 256 + ai * 128 + wr * 64 + m * 16 + fr; float sq = 0.f;
#pragma unroll
                for (int bj = 0; bj < 2; ++bj)
#pragma unroll
                    for (int n = 0; n < 2; ++n) { const size_t off = WO_OFF(q, mm, bj, n);
                        const f32x4 h = xv[q & 1][mm][bj][n] + acc[ai][bj][m][n];
                        if (!dry) *(f32x4*)(out + off) = h; u32x2 w; w.x = cvtpk(h[0], h[1]); w.y = cvtpk(h[2], h[3]); *(u32x2*)(h1b + off) = w;
                        sq += (h[0] * h[0] + h[1] * h[1]) + (h[2] * h[2] + h[3] * h[3]); }
                sq += __shfl_xor(sq, 16); sq += __shfl_xor(sq, 32);
                if (fq == 0) ss[(size_t)r * 16 + u.pn * 4 + wc] = sq; }
        }
#undef WO_LOAD
#undef WO_OFF
    }
};
struct EpiF1 {
    static constexpr bool PERM = true;
    const float* ss; bf16_t* hb;
    __device__ __forceinline__ void operator()(const f32x4 (&acc)[2][2][4][2], const Unit& u, int wr, int wc, int fr, int fq) const {
        float rsv[2][4];
#pragma unroll
        for (int ai = 0; ai < 2; ++ai) { f32x4 sv[4][4];
#pragma unroll
            for (int m = 0; m < 4; ++m) { const f32x4* sp = (const f32x4*)(ss + (size_t)(u.pm * 256 + ai * 128 + wr * 64 + m * 16 + fr) * 16);
#pragma unroll
                for (int k = 0; k < 4; ++k) sv[m][k] = sp[k]; }
#pragma unroll
            for (int m = 0; m < 4; ++m) { float tot = 0.f;
#pragma unroll
                for (int k = 0; k < 4; ++k) tot += (sv[m][k][0] + sv[m][k][1]) + (sv[m][k][2] + sv[m][k][3]);
                rsv[ai][m] = rsqrtf(tot * (1.0f / 1024.0f) + EPS); } }
#pragma unroll
        for (int ai = 0; ai < 2; ++ai)
#pragma unroll
            for (int m = 0; m < 4; ++m) { const int r = u.pm * 256 + ai * 128 + wr * 64 + m * 16 + fr; const float rs = rsv[ai][m];
#pragma unroll
                for (int bj = 0; bj < 2; ++bj) { f32x4 o0, o1;
#pragma unroll
                    for (int i = 0; i < 4; ++i) { const float a0 = fmaxf(acc[ai][bj][m][0][i] * rs, 0.f), a1 = fmaxf(acc[ai][bj][m][1][i] * rs, 0.f); o0[i] = a0 * a0; o1[i] = a1 * a1; }
                    *(u32x4*)(hb + (size_t)r * DFF + 256 * u.pn + 128 * bj + 32 * wc + 8 * fq) = pack8(o0, o1); } }
    }
};
struct EpiF2 {
    static constexpr bool PERM = false;
    float* out; int dry;
    __device__ __forceinline__ void operator()(const f32x4 (&acc)[2][2][4][2], const Unit& u, int wr, int wc, int fr, int fq) const {
        f32x4 xv[2][2][2][2];
#define F2_OFF(q, mm, bj, n) ((size_t)(u.pm * 256 + ((q) >> 1) * 128 + wr * 64 + (((q) & 1) * 2 + (mm)) * 16 + fr) * 1024 + 256 * u.pn + 128 * (bj) + 32 * wc + 16 * (n) + 4 * fq)
#define F2_LOAD(buf, q) do { _Pragma("unroll") for (int mm = 0; mm < 2; ++mm) _Pragma("unroll") for (int bj = 0; bj < 2; ++bj) _Pragma("unroll") for (int n = 0; n < 2; ++n) \
            xv[buf][mm][bj][n] = *(const f32x4*)(out + F2_OFF(q, mm, bj, n)); } while (0)
        F2_LOAD(0, 0);
#pragma unroll
        for (int q = 0; q < 4; ++q) {
            if (q + 1 < 4) { if (q & 1) F2_LOAD(0, q + 1); else F2_LOAD(1, q + 1); }
#pragma unroll
            for (int mm = 0; mm < 2; ++mm) { const int ai = q >> 1, m = (q & 1) * 2 + mm;
#pragma unroll
                for (int bj = 0; bj < 2; ++bj)
#pragma unroll
                    for (int n = 0; n < 2; ++n) { const f32x4 v = xv[q & 1][mm][bj][n] + acc[ai][bj][m][n]; if (!dry) *(f32x4*)(out + F2_OFF(q, mm, bj, n)) = v; } }
        }
#undef F2_LOAD
#undef F2_OFF
    }
};

template <bool SLOW>
__device__ __forceinline__ void attn_tile(const LAS unsigned char* kb, const LAS unsigned char* vb, const bf16x8 (&qf)[4], f32x16 (&o)[4], float& l,
                                          float cinit, int relb, int nvalid, const LAS float* lut, int i32, int hi) {
    f32x16 s0, s1;
#pragma unroll
    for (int r = 0; r < 16; ++r) { s0[r] = SLOW ? 0.f : cinit; s1[r] = SLOW ? 0.f : cinit; }
#pragma unroll
    for (int ds = 0; ds < 4; ++ds) {
        const bf16x8 k0 = *(const LAS bf16x8*)(kb + ((2 * ds + hi) * 64 + i32) * 16);
        const bf16x8 k1 = *(const LAS bf16x8*)(kb + ((2 * ds + hi) * 64 + 32 + i32) * 16);
        s0 = __builtin_amdgcn_mfma_f32_32x32x16_bf16(k0, qf[ds], s0, 0, 0, 0);
        s1 = __builtin_amdgcn_mfma_f32_32x32x16_bf16(k1, qf[ds], s1, 0, 0, 0);
    }
    if (SLOW) {
        const int base = relb + 8 * hi - i32 + 91;
#pragma unroll
        for (int r = 0; r < 16; ++r) {
            const int kap = (r & 3) + 4 * ((r >> 2) & 1) + 16 * (r >> 3);
            int i0 = base + kap, i1 = base + kap + 32;
            i0 = i0 < 0 ? 0 : (i0 > NLUT - 1 ? NLUT - 1 : i0); i1 = i1 < 0 ? 0 : (i1 > NLUT - 1 ? NLUT - 1 : i1);
            const float b0 = lut[i0], b1 = lut[i1];
            s0[r] = (kap + 8 * hi < nvalid) ? s0[r] + b0 : -INFINITY;
            s1[r] = (kap + 8 * hi + 32 < nvalid) ? s1[r] + b1 : -INFINITY;
        }
    }
    float sum = 0.f;
#pragma unroll
    for (int r = 0; r < 16; ++r) { s0[r] = __builtin_amdgcn_exp2f(s0[r]); s1[r] = __builtin_amdgcn_exp2f(s1[r]); sum += s0[r] + s1[r]; }
    l += sum;
    u32x4 pw[4];
#pragma unroll
    for (int i = 0; i < 4; ++i) { pw[0][i] = cvtpk(s0[2 * i], s0[2 * i + 1]); pw[1][i] = cvtpk(s0[8 + 2 * i], s0[8 + 2 * i + 1]);
                                  pw[2][i] = cvtpk(s1[2 * i], s1[2 * i + 1]); pw[3][i] = cvtpk(s1[8 + 2 * i], s1[8 + 2 * i + 1]); }
    if (SLOW) __builtin_amdgcn_sched_barrier(0);
#pragma unroll
    for (int eb = 0; eb < 4; ++eb)
#pragma unroll
        for (int s = 0; s < 4; ++s) {
            const bf16x8 vf = *(const LAS bf16x8*)(vb + ((2 * s + hi) * 128 + 32 * eb + i32) * 16);
            o[eb] = __builtin_amdgcn_mfma_f32_32x32x16_bf16(vf, __builtin_bit_cast(bf16x8, pw[s]), o[eb], 0, 0, 0);
        }
}

constexpr int ATT_KB = 0, ATT_VB = 32768, ATT_LUT = 65536, ATT_CMB = 67584;
__device__ __forceinline__ void attn_unit(LAS unsigned char* lds, int bh, int qb, bf16_t* qo, const bf16_t* kimg, const bf16_t* vimg, const bf16_t* kmeta, const bf16_t* vmeta,
                                          const float* lutg, int dry) {
    const int tid = threadIdx.x; int lane = tid & 63; asm volatile("" : "+v"(lane));
    const int i32 = lane & 31, hi = lane >> 5; const int wid = __builtin_amdgcn_readfirstlane(tid >> 6);
    const int b = bh >> 3, h = bh & 7, t = wid >> 2, qblk = wid & 3;
    const int q0 = qb * 128 + qblk * 32;
    const float lam = lutg[NH * NLUT];
    LAS float* lut = (LAS float*)(lds + ATT_LUT);
    if (tid < NLUT) lut[tid] = lutg[h * NLUT + tid];
    const unsigned char* ksrc = (const unsigned char*)kimg + (size_t)bh * 64 * 16384;
    const unsigned char* vsrc = (const unsigned char*)vimg + (size_t)bh * 64 * 16384;
    const unsigned char* kms = (const unsigned char*)kmeta + (size_t)h * 16384;
    const unsigned char* vms = (const unsigned char*)vmeta + (size_t)h * 16384;
#define ATT_DMA(j, buf) do { const unsigned char* ks_ = ((j) < 64) ? ksrc + (size_t)(j) * 16384 : kms; const unsigned char* vs_ = ((j) < 64) ? vsrc + (size_t)(j) * 16384 : vms; \
        _Pragma("unroll") for (int p_ = 0; p_ < 2; ++p_) { const int pc_ = wid + 8 * p_; \
            __builtin_amdgcn_global_load_lds((const unsigned*)(ks_ + pc_ * 1024 + lane * 16), (LAS unsigned*)(lds + ATT_KB + (buf) * 16384 + pc_ * 1024), 16, 0, 0); \
            __builtin_amdgcn_global_load_lds((const unsigned*)(vs_ + pc_ * 1024 + lane * 16), (LAS unsigned*)(lds + ATT_VB + (buf) * 16384 + pc_ * 1024), 16, 0, 0); } } while (0)
    ATT_DMA(0, 0);
    bf16x8 qf[4];
    { const bf16_t* qp = qo + ((size_t)b * SEQ + q0 + i32) * 1024 + h * 128 + t * 64 + hi * 8;
#pragma unroll
      for (int ds = 0; ds < 4; ++ds) qf[ds] = *(const bf16x8*)(qp + ds * 16); }
    f32x16 o[4];
#pragma unroll
    for (int eb = 0; eb < 4; ++eb)
#pragma unroll
        for (int r = 0; r < 16; ++r) o[eb][r] = 0.f;
    float l = 0.f;
    asm volatile("s_waitcnt vmcnt(0)" ::: "memory");
    __syncthreads();
    const float cneg = lut[0], cpos = lut[NLUT - 1];
    for (int j = 0; j < 65; ++j) {
        const int buf = j & 1;
        if (j + 1 < 65) ATT_DMA(j + 1, buf ^ 1);
        const LAS unsigned char* kb = lds + ATT_KB + buf * 16384 + t * 8192; const LAS unsigned char* vb = lds + ATT_VB + buf * 16384;
        const int lo = 64 * j - (q0 + 31), hi_ = 64 * j + 63 - q0;
        if (j < 64 && (hi_ <= -91 || lo >= 91)) attn_tile<false>(kb, vb, qf, o, l, (hi_ <= -91) ? cneg : cpos, 0, 64, lut, i32, hi);
        else attn_tile<true>(kb, vb, qf, o, l, 0.f, (j < 64) ? 64 * j - q0 : -NMETA - q0, (j < 64) ? 64 : NMETA, lut, i32, hi);
        asm volatile("s_waitcnt vmcnt(0)" ::: "memory");
        __syncthreads();
    }
#undef ATT_DMA
    const float lt = l + __shfl_xor(l, 32);
    LAS float* cmb = (LAS float*)(lds + ATT_CMB) + qblk * 4096 + lane;
    if (t == 1) { const float sc = lam / lt;
#pragma unroll
        for (int eb = 0; eb < 4; ++eb)
#pragma unroll
            for (int r = 0; r < 16; ++r) cmb[(eb * 16 + r) * 64] = o[eb][r] * sc; }
    __syncthreads();
    if (t == 0 && !dry) { const float sc = 1.0f / lt; float ssq = 0.f;
#pragma unroll
        for (int eb = 0; eb < 4; ++eb)
#pragma unroll
            for (int r = 0; r < 16; ++r) { const float v = o[eb][r] * sc - cmb[(eb * 16 + r) * 64]; o[eb][r] = v; ssq += v * v; }
        ssq += __shfl_xor(ssq, 32);
        const float rs = rsqrtf(ssq * (1.0f / 128.0f) + EPS);
        bf16_t* op = qo + ((size_t)b * SEQ + q0 + i32) * 1024 + h * 128 + 4 * hi;
#pragma unroll
        for (int eb = 0; eb < 4; ++eb)
#pragma unroll
            for (int g = 0; g < 4; ++g) { u32x2 w; w.x = cvtpk(o[eb][4 * g] * rs, o[eb][4 * g + 1] * rs); w.y = cvtpk(o[eb][4 * g + 2] * rs, o[eb][4 * g + 3] * rs);
                *(u32x2*)(op + 32 * eb + 8 * g) = w; }
    }
}

#define XB_TMO      128
#define XB_XCNT(j)  (256  + 64 * (j))
#define XB_XSUB(j)  (1280 + 64 * (j))
#define XB_XGEN(j)  (2304 + 64 * (j))
#define XB_TOP      3328
#define XB_TOPGEN   3392
#define XCD_BAR_WORDS 3456
#define XB_SPIN_CAP (1u << 20)
__device__ __forceinline__ unsigned xb_ld(unsigned* p)              { return __hip_atomic_load(p, __ATOMIC_RELAXED, __HIP_MEMORY_SCOPE_AGENT); }
__device__ __forceinline__ unsigned xb_add(unsigned* p, unsigned v) { return __hip_atomic_fetch_add(p, v, __ATOMIC_RELAXED, __HIP_MEMORY_SCOPE_AGENT); }
__device__ __forceinline__ unsigned xb_xcc_id() { return (unsigned)__builtin_amdgcn_s_getreg((3 << 11) | 20) & 0xFu; }
#define XB_SPIN(cond, bar) do { unsigned _sp = 0; while (cond) { __builtin_amdgcn_s_sleep(1); \
    if ((++_sp & 255u) == 0u) { if (xb_ld(&(bar)[XB_TMO])) break; if (_sp > XB_SPIN_CAP) { atomicAdd(&(bar)[XB_TMO], 1u); break; } } } } while (0)
struct XcdBarrier { unsigned* bar; unsigned x; volatile LAS unsigned* st; };
__device__ __forceinline__ XcdBarrier xcd_barrier_post(unsigned* bar, volatile LAS unsigned* st) {
    XcdBarrier b; b.bar = bar; b.x = xb_xcc_id(); b.st = st;
    if (threadIdx.x == 0) (void)xb_add(&bar[XB_XCNT(b.x)], 1u);
    return b;
}
__device__ __forceinline__ void xcd_barrier_complete(unsigned* bar, unsigned x, unsigned& nloc, unsigned& nx) {
    const unsigned G = gridDim.x * gridDim.y * gridDim.z;
    unsigned sum, cnt, mine, sp = 0u;
    for (;;) {
        sum = 0u; cnt = 0u; mine = 0u;
#pragma unroll
        for (unsigned j = 0; j < 16; ++j) { const unsigned c = xb_ld(&bar[XB_XCNT(j)]); sum += c; cnt += (c > 0u) ? 1u : 0u; mine = (j == x) ? c : mine; }
        if (sum == G) break;
        __builtin_amdgcn_s_sleep(1);
        if ((++sp & 255u) == 0u) { if (xb_ld(&bar[XB_TMO])) break; if (sp > XB_SPIN_CAP) { atomicAdd(&bar[XB_TMO], 1u); break; } }
    }
    nloc = mine > 0u ? mine : 1u; nx = cnt > 0u ? cnt : 1u;
}
__device__ __forceinline__ void xcd_barrier(const XcdBarrier& b) {
    asm volatile("s_waitcnt vmcnt(0)" ::: "memory");
    __syncthreads();
    if (threadIdx.x == 0) {
        unsigned* bar = b.bar;
        __builtin_amdgcn_s_waitcnt(0);
        unsigned nloc = b.st[0], nx = b.st[1];
        if (nloc == 0u) { xcd_barrier_complete(bar, b.x, nloc, nx); b.st[0] = nloc; b.st[1] = nx; }
        const unsigned old = xb_add(&bar[XB_XSUB(b.x)], 1u);
        const unsigned gen = old / nloc;
        if (old + 1u == (gen + 1u) * nloc) {
            __builtin_amdgcn_fence(__ATOMIC_RELEASE, "agent");
            asm volatile("s_waitcnt vmcnt(0)" ::: "memory");
            const unsigned og = xb_add(&bar[XB_TOP], 1u);
            const unsigned tg = og / nx;
            if (og + 1u == (tg + 1u) * nx) xb_add(&bar[XB_TOPGEN], 1u);
            else XB_SPIN(xb_ld(&bar[XB_TOPGEN]) == tg, bar);
            __builtin_amdgcn_fence(__ATOMIC_ACQUIRE, "agent");
            xb_add(&bar[XB_XGEN(b.x)], 1u);
            asm volatile("s_waitcnt vmcnt(0)" ::: "memory");
        } else {
            XB_SPIN(xb_ld(&bar[XB_XGEN(b.x)]) == gen, bar);
            __builtin_amdgcn_fence(__ATOMIC_ACQUIRE, "agent");
            asm volatile("s_waitcnt vmcnt(0)" ::: "memory");
        }
    }
    __syncthreads();
}

struct Params {
    const float* in[27]; float* out; unsigned char* ws;
};
__device__ __forceinline__ float wave_sum(float v) {
#pragma unroll
    for (int o = 1; o < 64; o <<= 1) v += __shfl_xor(v, o);
    return v;
}
__device__ __forceinline__ void tr_item(const float* W, int ldw, int col0, int k0, bf16_t* WT, int K, int n0, const float* ksc, int kmask, float kmul, LAS float* scr, int lane) {
#pragma unroll 8
    for (int i = 0; i < 32; ++i) { const int kk = 2 * i + (lane >> 5); float s = kmul; if (ksc) s *= ksc[(k0 + kk) & kmask];
        scr[kk * 33 + (lane & 31)] = W[(size_t)(k0 + kk) * ldw + col0 + (lane & 31)] * s; }
    asm volatile("s_waitcnt lgkmcnt(0)" ::: "memory");
    const int c = lane & 7;
#pragma unroll
    for (int jj = 0; jj < 4; ++jj) { const int n = (lane >> 3) + 8 * jj; const LAS float* s = scr + (8 * c) * 33 + n;
        u32x4 o; o.x = cvtpk(s[0 * 33], s[1 * 33]); o.y = cvtpk(s[2 * 33], s[3 * 33]); o.z = cvtpk(s[4 * 33], s[5 * 33]); o.w = cvtpk(s[6 * 33], s[7 * 33]);
        *(u32x4*)(WT + (size_t)(n0 + n) * K + k0 + 8 * c) = o; }
    asm volatile("s_waitcnt lgkmcnt(0)" ::: "memory");
}
__device__ __forceinline__ int rel_bucket(int rel) {
    const int n = rel < 0 ? -rel : rel; int bk;
    if (n < 8) bk = n; else { bk = (31 - __builtin_clz((unsigned)(n * n))) + 2; if (bk > 15) bk = 15; }
    return (rel > 0 ? 16 : 0) + bk;
}

__device__ __forceinline__ void s5_prep_part(const Params& P, int g, int part, LAS unsigned char* lds) {
    const float* lam_re = P.in[5]; const float* lam_im = P.in[6]; const float* log_step = P.in[7];
    const float* b_re = P.in[8]; const float* b_im = P.in[9]; const float* c_re = P.in[10]; const float* c_im = P.in[11]; const float* dsk = P.in[12];
    bf16_t* mgt = (bf16_t*)(P.ws + WS_MGT) + (size_t)g * 512 * KY;
    bf16_t* wst = (bf16_t*)(P.ws + WS_WSTT) + (size_t)g * 256 * 512;
    const int tid = threadIdx.x;
    LAS float* apw = (LAS float*)lds;
    LAS float* coef = apw + 2 * 33 * 64 * 2;
    LAS float* kt = coef + 2 * 64 * 2;
    if (tid < 128) {
        const int dr = tid >> 6, p = tid & 63;
        const float dt = expf(log_step[dr * S5G + g]); const float lr = lam_re[(dr * S5G + g) * S5P + p], li = lam_im[(dr * S5G + g) * S5P + p];
        float sn, cs; sincosf(li * dt, &sn, &cs); const float mg = expf(lr * dt); const float ar = mg * cs, ai = mg * sn, den = lr * lr + li * li;
        coef[(dr * 64 + p) * 2] = ((ar - 1.0f) * lr + ai * li) / den; coef[(dr * 64 + p) * 2 + 1] = (ai * lr - (ar - 1.0f) * li) / den;
        float xr = 1.f, xi = 0.f;
        for (int tau = 0; tau <= 32; ++tau) { apw[((dr * 33 + tau) * 64 + p) * 2] = xr; apw[((dr * 33 + tau) * 64 + p) * 2 + 1] = xi;
            const float nr = xr * ar - xi * ai, ni = xr * ai + xi * ar; xr = nr; xi = ni; }
    }
    __syncthreads();
    {
        const int dr = tid >> 8, cl = (tid >> 7) & 1, c = (tid >> 3) & 15, tq = tid & 7, cp = 2 * part + cl;
        float a0 = 0.f, a1 = 0.f, a2 = 0.f, a3 = 0.f;
#pragma unroll 4
        for (int p = 0; p < 64; ++p) {
            const float cr = c_re[((dr * S5G + g) * S5C + cp) * S5P + p], ci = c_im[((dr * S5G + g) * S5C + cp) * S5P + p];
            const float br = b_re[((dr * S5G + g) * S5P + p) * S5C + c], bi = b_im[((dr * S5G + g) * S5P + p) * S5C + c];
            const float kr = coef[(dr * 64 + p) * 2], ki = coef[(dr * 64 + p) * 2 + 1];
            const float btr = kr * br - ki * bi, bti = kr * bi + ki * br;
            const float wr_ = cr * btr - ci * bti, wi_ = cr * bti + ci * btr;
            const LAS float* ap = apw + ((dr * 33 + 4 * tq) * 64 + p) * 2;
            a0 += wr_ * ap[0] - wi_ * ap[1]; a1 += wr_ * ap[128] - wi_ * ap[129]; a2 += wr_ * ap[256] - wi_ * ap[257]; a3 += wr_ * ap[384] - wi_ * ap[385];
        }
        LAS float* kp = kt + ((dr * 32 + 4 * tq) * 2 + cl) * 16 + c;
        kp[0] = a0; kp[32] = a1; kp[64] = a2; kp[96] = a3;
    }
    __syncthreads();
    for (int idx = tid; idx < 64 * 64; idx += 512) {
        const int rl = idx >> 6, kc = idx & 63, tp = rl >> 1, cl = rl & 1, cp = 2 * part + cl, n = tp * 16 + cp, t = kc >> 1, c0 = (kc & 1) * 8, tau = tp - t;
        float v[8];
#pragma unroll
        for (int i = 0; i < 8; ++i) { const int c = c0 + i; float x;
            if (tau > 0) x = kt[((0 * 32 + tau) * 2 + cl) * 16 + c]; else if (tau < 0) x = kt[((1 * 32 - tau) * 2 + cl) * 16 + c];
            else { x = kt[cl * 16 + c] + kt[(32 * 2 + cl) * 16 + c]; if (c == cp) x += dsk[g * 16 + cp]; }
            v[i] = x; }
        u32x4 w; w.x = cvtpk(v[0], v[1]); w.y = cvtpk(v[2], v[3]); w.z = cvtpk(v[4], v[5]); w.w = cvtpk(v[6], v[7]);
        *(u32x4*)(mgt + (size_t)n * KY + kc * 8) = w;
    }
    for (int idx = tid; idx < 64 * 32; idx += 512) {
        const int rl = idx >> 5, pc = idx & 31, tp = rl >> 1, cp = 2 * part + (rl & 1), n = tp * 16 + cp, kq = pc * 8, dr = kq >> 7, reim = (kq >> 6) & 1, p0 = kq & 63;
        const int te = dr ? (32 - tp) : (tp + 1);
        float v[8];
#pragma unroll
        for (int i = 0; i < 8; ++i) { const int p = p0 + i;
            const float cr = c_re[((dr * S5G + g) * S5C + cp) * S5P + p], ci = c_im[((dr * S5G + g) * S5C + cp) * S5P + p];
            const float pr = apw[((dr * 33 + te) * 64 + p) * 2], pim = apw[((dr * 33 + te) * 64 + p) * 2 + 1];
            v[i] = reim ? -(cr * pim + ci * pr) : (cr * pr - ci * pim); }
        u32x4 w; w.x = cvtpk(v[0], v[1]); w.y = cvtpk(v[2], v[3]); w.z = cvtpk(v[4], v[5]); w.w = cvtpk(v[6], v[7]);
        *(u32x4*)(mgt + (size_t)n * KY + 512 + kq) = w;
    }
    for (int idx = tid; idx < 32 * 64; idx += 512) {
        const int rl = idx >> 6, kc = idx & 63, dr = rl >> 4, reim = (rl >> 3) & 1, p = 8 * part + (rl & 7), n = dr * 128 + reim * 64 + p, t = kc >> 1, c0 = (kc & 1) * 8;
        const int te = dr ? t : (31 - t);
        const float pr = apw[((dr * 33 + te) * 64 + p) * 2], pim = apw[((dr * 33 + te) * 64 + p) * 2 + 1];
        const float kr = coef[(dr * 64 + p) * 2], ki = coef[(dr * 64 + p) * 2 + 1];
        float v[8];
#pragma unroll
        for (int i = 0; i < 8; ++i) { const int c = c0 + i;
            const float br = b_re[((dr * S5G + g) * S5P + p) * S5C + c], bi = b_im[((dr * S5G + g) * S5P + p) * S5C + c];
            const float btr = kr * br - ki * bi, bti = kr * bi + ki * br;
            v[i] = reim ? (pr * bti + pim * btr) : (pr * btr - pim * bti); }
        u32x4 w; w.x = cvtpk(v[0], v[1]); w.y = cvtpk(v[2], v[3]); w.z = cvtpk(v[4], v[5]); w.w = cvtpk(v[6], v[7]);
        *(u32x4*)(wst + (size_t)n * 512 + kc * 8) = w;
    }
    __syncthreads();
}

#define PH(k) if constexpr ((MASK >> (k)) & 1)
#define GSYNC() do { if constexpr (MASK == 0xFFFF) xcd_barrier(xbar); } while (0)
#define GSYNC_CG() do { if constexpr (MASK == 0xFFFF) cg::this_grid().sync(); } while (0)
#define PROBE_MASK 0
constexpr int LDS_BYTES = 135168;
template <int MASK, int DRY>
__global__ void __launch_bounds__(512, 2) fwd_megakernel(Params P) {
    extern __shared__ __attribute__((aligned(16))) unsigned char lds_raw[];
    LAS unsigned char* lds = (LAS unsigned char*)lds_raw;
    const int tid = threadIdx.x, lane = tid & 63, wave = __builtin_amdgcn_readfirstlane(tid >> 6);
    const int G = gridDim.x, bx = blockIdx.x;
    const int vcu = (G % 8 == 0) ? (bx % 8) * (G / 8) + bx / 8 : bx;
    unsigned char* ws = P.ws;
    const float* x = P.in[0];
    volatile LAS unsigned* xst = (volatile LAS unsigned*)(lds + LDS_BYTES - 64);
    XcdBarrier xbar; xbar.bar = (unsigned*)(ws + WS_CTL); xbar.x = 0; xbar.st = xst;
    if constexpr (MASK == 0xFFFF || (MASK & 0x1000)) { if (tid < 2) xst[tid] = 0u; __syncthreads(); xbar = xcd_barrier_post((unsigned*)(ws + WS_CTL + (MASK == 0xFFFF ? 0 : 16 * 1024)), xst); }
    const int dry = DRY ? (int)(((const volatile float*)(ws + WS_LUT))[NH * NLUT + 1] != 12345.0f) : 0;
#define XB ((bf16_t*)(ws + WS_XB))
#define RSTD1 ((float*)(ws + WS_RSTD1))
#define WIN ((bf16_t*)(ws + WS_WIN))
#define WGLU ((bf16_t*)(ws + WS_WGLU))
#define WAO ((bf16_t*)(ws + WS_WAO))
#define WWO ((bf16_t*)(ws + WS_WWO))
#define WF1 ((bf16_t*)(ws + WS_WF1))
#define WF2 ((bf16_t*)(ws + WS_WF2))
#define QO ((bf16_t*)(ws + WS_QO))
#define KIMG ((bf16_t*)(ws + WS_KIMG))
#define VIMG ((bf16_t*)(ws + WS_VIMG))
#define KMETA ((bf16_t*)(ws + WS_KMETA))
#define VMETA ((bf16_t*)(ws + WS_VMETA))
#define G1 ((bf16_t*)(ws + WS_G1))
#define G2 ((bf16_t*)(ws + WS_G2))
#define MGT ((bf16_t*)(ws + WS_MGT))
#define UGS ((bf16_t*)(ws + WS_UGS))
#define WSTT ((bf16_t*)(ws + WS_WSTT))
#define SLOC ((float*)(ws + WS_SLOC))
#define GY ((bf16_t*)(ws + WS_GY))
#define H1B ((bf16_t*)(ws + WS_H1B))
#define HBUF ((bf16_t*)(ws + WS_HBUF))
#define SS ((float*)(ws + WS_SS))
#define LUT ((float*)(ws + WS_LUT))
#define UMETA ((float*)(ws + WS_UMETA))

    PH(0) {
        for (int task = bx; task < S5G * 8; task += G) s5_prep_part(P, task >> 3, task & 7, lds);
        if (bx == G - 1) {
            const float* tab = P.in[2];
            for (int idx = tid; idx < NH * NLUT; idx += 512) { const int h = idx / NLUT, rel = idx % NLUT - 91; LUT[idx] = tab[rel_bucket(rel) * NH + h] * LOG2E; }
            if (wave == 0) { const float a = wave_sum(P.in[17][lane] * P.in[18][lane]), c = wave_sum(P.in[19][lane] * P.in[20][lane]);
                if (lane == 0) LUT[NH * NLUT] = expf(a) - expf(c) + 0.2f; }
        }
        LAS float* scr = (LAS float*)(lds + wave * 8704);
        const int gw = vcu * 8 + wave, NGW = G * 8;
        constexpr int I0 = 16 * 144, I1 = 16 * 32, I2 = 8 * 64, I3 = 16 * 32, I4 = 16 * 32, I5 = 16 * 128, I6 = 64 * 32;
        constexpr int NITEMS = I0 + I1 + I2 + I3 + I4 + I5 + I6;
        for (int it = gw; it < NITEMS; it += NGW) {
            int r = it;
            if (r < I0) { const int kb = r / 144, nb = r % 144, n0 = 32 * nb, pn = n0 >> 8, rho = n0 & 255; const int mc = 256 * pn + 64 * ((rho >> 5) & 3) + 32 * (rho >> 7);
                tr_item(P.in[4], 5632, mc < 2560 ? mc : mc + 1024, 64 * kb, WIN, 1024, n0, P.in[3], 1023, 1.0f, scr, lane); continue; } r -= I0;
            if (r < I1) { const int kb = r / 32, nb = r % 32; tr_item(P.in[4], 5632, 2560 + 32 * nb, 64 * kb, WIN + (size_t)4608 * 1024, 1024, 32 * nb, P.in[3], 1023, 1.0f, scr, lane); continue; } r -= I1;
            if (r < I2) { const int kb = r / 64, nb = r % 64, n0 = 32 * nb, pn = n0 >> 8, rho = n0 & 255;
                tr_item((rho >> 7) ? P.in[14] : P.in[13], 1024, 128 * pn + (rho & 127), 64 * kb, WGLU, 512, n0, nullptr, 0, 1.0f, scr, lane); continue; } r -= I2;
            if (r < I3) { const int kb = r / 32, nb = r % 32; tr_item(P.in[22], 1024, 32 * nb, 64 * kb, WAO, 1024, 32 * nb, P.in[21], 127, 0.8f, scr, lane); continue; } r -= I3;
            if (r < I4) { const int kb = r / 32, nb = r % 32; tr_item(P.in[23], 1024, 32 * nb, 64 * kb, WWO, 1024, 32 * nb, nullptr, 0, 1.0f, scr, lane); continue; } r -= I4;
            if (r < I5) { const int kb = r / 128, nb = r % 128; tr_item(P.in[25], 4096, 32 * nb, 64 * kb, WF1, 1024, 32 * nb, P.in[24], 1023, 1.0f, scr, lane); continue; } r -= I5;
            { const int kb = r / 32, nb = r % 32; tr_item(P.in[26], 1024, 32 * nb, 64 * kb, WF2, 4096, 32 * nb, nullptr, 0, 1.0f, scr, lane); }
        }
        for (int r0 = gw * 4; r0 < MPAD; r0 += NGW * 4) {
            f32x4 v[4][4];
#pragma unroll
            for (int q = 0; q < 4; ++q) { const int r = r0 + q;
                if (r < MTOK + NMETA) { const f32x4* xr = (const f32x4*)((r < MTOK) ? x + (size_t)r * D : P.in[1] + (size_t)(r - MTOK) * D) + lane;
#pragma unroll
                    for (int j = 0; j < 4; ++j) v[q][j] = xr[64 * j];
                } else {
#pragma unroll
                    for (int j = 0; j < 4; ++j) v[q][j] = (f32x4){0.f, 0.f, 0.f, 0.f};
                } }
#pragma unroll
            for (int q = 0; q < 4; ++q) { const int r = r0 + q; float sq = 0.f;
#pragma unroll
                for (int j = 0; j < 4; ++j) sq += (v[q][j][0] * v[q][j][0] + v[q][j][1] * v[q][j][1]) + (v[q][j][2] * v[q][j][2] + v[q][j][3] * v[q][j][3]);
                sq = wave_sum(sq);
                if (lane == 0) RSTD1[r] = rsqrtf(sq * (1.0f / D) + EPS);
                u32x2* o8 = (u32x2*)(XB + (size_t)r * D) + lane;
#pragma unroll
                for (int j = 0; j < 4; ++j) { u32x2 w; w.x = cvtpk(v[q][j][0], v[q][j][1]); w.y = cvtpk(v[q][j][2], v[q][j][3]); o8[64 * j] = w; } }
        }
    }
    GSYNC_CG();

    PH(1) {
        pg8::Gemm g{XB, WIN, 1024, 1024, 1024}; pg8::StaticOrder S; S.init(MTOK / 256, 18, G, bx);
        EpiInMain E{RSTD1, UGS, UMETA, QO, KIMG, KMETA, G1, G2, P.in[15], P.in[16]};
        pg8::gemm_phase<EpiInMain, pg8::StaticOrder, false>(lds, g, S, E);
    }
    PH(11) {
        pg8::Gemm g{XB, WIN + (size_t)4608 * 1024, 1024, 1024, 1024}; pg8::StaticOrder S; S.init(MTOK / 256, 4, G, bx);
        EpiInV E{RSTD1, VIMG, VMETA};
        pg8::gemm_phase<EpiInV, pg8::StaticOrder, true>(lds, g, S, E);
    }
    GSYNC();
    PH(12) { for (int xs = 0; xs < 10; ++xs) xcd_barrier(xbar); }

    PH(2) {
        if (G < 150 || bx < G - 22) {
            pg8::Gemm g{UGS, WSTT, KY, 512, 512}; pg8::GroupOrder<4, 1> S{G < 150 ? G : G - 22, bx};
            EpiSloc E{SLOC};
            pg8::gemm_phase<EpiSloc, pg8::GroupOrder<4, 1>, false>(lds, g, S, E);
        }
        if (G < 150 || bx >= G - 4) {
            pg8::Gemm g{XB, WIN + (size_t)4608 * 1024, 1024, 1024, 1024}; pg8::PanelOrder S{MTOK / 256, 4, G < 150 ? G : 4, G < 150 ? bx : bx - (G - 4)};
            EpiInV E{RSTD1, VIMG, VMETA};
            pg8::gemm_phase<EpiInV, pg8::PanelOrder, true>(lds, g, S, E);
        }
        if (G < 150 || (bx >= G - 22 && bx < G - 4)) {
            pg8::Gemm g{XB, WIN, 1024, 1024, 1024}; pg8::PanelOrder S{MTOK / 256, 18, G < 150 ? G : 18, G < 150 ? bx : bx - (G - 22)};
            EpiInMain E{RSTD1, UGS, UMETA, QO, KIMG, KMETA, G1, G2, P.in[15], P.in[16]};
            pg8::gemm_phase<EpiInMain, pg8::PanelOrder, false>(lds, g, S, E);
        }
    }
    GSYNC();

    PH(3) {
        const int gid = bx * 512 + tid;
        if (gid < S5G * BATCH * 2 * S5P) {
            const int p = gid & 63, dr = (gid >> 6) & 1, b = (gid >> 7) & 7, g = gid >> 10;
            const float dt = expf(P.in[7][dr * S5G + g]); const float lr = P.in[5][(dr * S5G + g) * S5P + p], li = P.in[6][(dr * S5G + g) * S5P + p];
            float sn, cs; sincosf(li * dt, &sn, &cs); const float mg = expf(lr * dt); const float a1r = mg * cs, a1i = mg * sn;
            sincosf(li * dt * 32.0f, &sn, &cs); const float mg32 = expf(lr * dt * 32.0f); const float ar = mg32 * cs, ai = mg32 * sn;
            float sr = 0.f, si = 0.f;
            if (dr == 0) {
                const float den = lr * lr + li * li; const float kr = ((a1r - 1.0f) * lr + a1i * li) / den, ki = (a1i * lr - (a1r - 1.0f) * li) / den;
                float btr[16], bti[16];
#pragma unroll
                for (int c = 0; c < 16; ++c) { const float br = P.in[8][((size_t)g * S5P + p) * S5C + c], bi = P.in[9][((size_t)g * S5P + p) * S5C + c]; btr[c] = kr * br - ki * bi; bti[c] = kr * bi + ki * br; }
                for (int m = 0; m < NMETA; ++m) { float xr = 0.f, xi = 0.f;
#pragma unroll
                    for (int c = 0; c < 16; ++c) { const float uv = UMETA[m * S5W + g * 16 + c]; xr += btr[c] * uv; xi += bti[c] * uv; }
                    const float nr = a1r * sr - a1i * si + xr, ni = a1r * si + a1i * sr + xi; sr = nr; si = ni; }
            }
            const size_t rbase = (size_t)g * 1024 + b * 128;
            const float* sl = SLOC + rbase * 256 + dr * 128 + p; bf16_t* so = UGS + rbase * KY + 512 + dr * 128 + p;
            for (int i0 = 0; i0 < NCH; i0 += 16) {
                float lre[16], lim[16];
#pragma unroll
                for (int k = 0; k < 16; ++k) { const int ch = dr ? (NCH - 1 - (i0 + k)) : (i0 + k); lre[k] = sl[(size_t)ch * 256]; lim[k] = sl[(size_t)ch * 256 + 64]; }
#pragma unroll
                for (int k = 0; k < 16; ++k) { const int ch = dr ? (NCH - 1 - (i0 + k)) : (i0 + k);
                    so[(size_t)ch * KY] = (bf16_t)(cvtpk(sr, sr) & 0xffffu); so[(size_t)ch * KY + 64] = (bf16_t)(cvtpk(si, si) & 0xffffu);
                    const float nr = ar * sr - ai * si + lre[k], ni = ar * si + ai * sr + lim[k]; sr = nr; si = ni; }
            }
        }
    }
    GSYNC();

    PH(4) {
        pg8::Gemm g{UGS, MGT, KY, KY, KY}; pg8::GroupOrder<4, 2> S{G, bx};
        EpiY E{GY};
        pg8::gemm_phase<EpiY, pg8::GroupOrder<4, 2>, false>(lds, g, S, E);
    }
    GSYNC();

    PH(5) {
        pg8::Gemm g{GY, WGLU, 512, 512, 512}; pg8::StaticOrder S; S.init(MTOK / 256, 8, G, bx);
        EpiGlu E{G1, dry};
        pg8::gemm_phase<EpiGlu, pg8::StaticOrder, false>(lds, g, S, E);
    }
    PH(6) {
        const int nunits = BATCH * NH * (SEQ / 128);
        for (int i = 0; ; ++i) {
            int bh, qb;
            if (G == 256) { if (i >= 8) break; bh = (vcu >> 5) * 8 + i; qb = vcu & 31; }
            else { const int U = i * G + bx; if (U >= nunits) break; bh = U >> 5; qb = U & 31; }
            attn_unit(lds, bh, qb, QO, KIMG, VIMG, KMETA, VMETA, LUT, dry);
        }
    }
    GSYNC();

    PH(7) {
        pg8::Gemm g{QO, WAO, 1024, 1024, 1024}; pg8::StaticOrder S; S.init(MTOK / 256, 4, G, bx);
        EpiAo E{G1, G2, dry};
        pg8::gemm_phase<EpiAo, pg8::StaticOrder, false>(lds, g, S, E);
    }
    GSYNC();

    PH(8) {
        pg8::Gemm g{G2, WWO, 1024, 1024, 1024}; pg8::StaticOrder S; S.init(MTOK / 256, 4, G, bx);
        EpiWo E{x, P.out, H1B, SS, dry};
        pg8::gemm_phase<EpiWo, pg8::StaticOrder, false>(lds, g, S, E);
    }
    GSYNC();

    PH(9) {
        pg8::Gemm g{H1B, WF1, 1024, 1024, 1024}; pg8::StaticOrder S; S.init(MTOK / 256, 16, G, bx);
        EpiF1 E{SS, HBUF};
        pg8::gemm_phase<EpiF1, pg8::StaticOrder, false>(lds, g, S, E);
    }
    GSYNC();

    PH(10) {
        pg8::Gemm g{HBUF, WF2, 4096, 4096, 4096}; pg8::StaticOrder S; S.init(MTOK / 256, 4, G, bx);
        EpiF2 E{P.out, dry};
        pg8::gemm_phase<EpiF2, pg8::StaticOrder, false>(lds, g, S, E);
    }
}

extern "C" void kernel_launch(void* const* d_in, const int* in_sizes, int n_in, void* d_out, int out_size, void* d_ws, size_t ws_size, hipStream_t stream) {
    static int grid = 0;
    if (grid == 0) {
        if (n_in != 27 || ws_size < WS_END) { fprintf(stderr, "kernel_launch: unexpected inputs (n_in %d, ws %zu)\n", n_in, ws_size); grid = -1; return; }
        int dev = 0, cus = 0, per_cu = 0;
        (void)hipGetDevice(&dev); (void)hipDeviceGetAttribute(&cus, hipDeviceAttributeMultiprocessorCount, dev);
        (void)hipFuncSetAttribute((const void*)fwd_megakernel<0xFFFF, 0>, hipFuncAttributeMaxDynamicSharedMemorySize, LDS_BYTES);
        if (hipOccupancyMaxActiveBlocksPerMultiprocessor(&per_cu, (const void*)fwd_megakernel<0xFFFF, 0>, 512, LDS_BYTES) != hipSuccess || per_cu < 1) per_cu = 1;
        (void)hipGetLastError();
        grid = cus * 1;
        if (grid <= 0) grid = 256;
    }
    if (grid < 0) return;
    Params p{};
    for (int i = 0; i < 27; ++i) p.in[i] = (const float*)d_in[i];
    p.out = (float*)d_out; p.ws = (unsigned char*)d_ws;
    (void)hipMemsetAsync((char*)d_ws + WS_CTL, 0, CTL_BYTES, stream);
    void* args[] = {&p};
    hipError_t e = hipLaunchCooperativeKernel((const void*)fwd_megakernel<0xFFFF, 0>, dim3(grid), dim3(512), args, LDS_BYTES, stream);
    if (e != hipSuccess) fprintf(stderr, "cooperative launch failed: %s (grid %d)\n", hipGetErrorString(e), grid);
#if PROBE_MASK
    (void)hipFuncSetAttribute((const void*)fwd_megakernel<PROBE_MASK, 1>, hipFuncAttributeMaxDynamicSharedMemorySize, LDS_BYTES);
    if (PROBE_MASK & 0x1000) (void)hipLaunchCooperativeKernel((const void*)fwd_megakernel<PROBE_MASK, 1>, dim3(grid), dim3(512), args, LDS_BYTES, stream);
    else hipLaunchKernelGGL((fwd_megakernel<PROBE_MASK, 1>), dim3(grid), dim3(512), LDS_BYTES, stream, p);
#endif
}
```

```cpp
#include <hip/hip_runtime.h>
#include <hip/hip_cooperative_groups.h>
#include <cstdio>
#include <cstdint>
namespace cg = cooperative_groups;

#define LAS __attribute__((address_space(3)))
typedef unsigned short bf16_t;
typedef short bf16x8 __attribute__((ext_vector_type(8)));
typedef float f32x4 __attribute__((ext_vector_type(4)));
typedef float f32x16 __attribute__((ext_vector_type(16)));
typedef unsigned u32x4 __attribute__((ext_vector_type(4)));
typedef unsigned u32x2 __attribute__((ext_vector_type(2)));
typedef float f32x2_t __attribute__((ext_vector_type(2)));
typedef __bf16 bf16x2_t __attribute__((ext_vector_type(2)));

__device__ __forceinline__ unsigned cvtpk(float lo, float hi) { f32x2_t v = {lo, hi}; bf16x2_t b = __builtin_convertvector(v, bf16x2_t); return __builtin_bit_cast(unsigned, b); }
__device__ __forceinline__ float bf2f(unsigned short h) { return __uint_as_float(((unsigned)h) << 16); }
__device__ __forceinline__ float sigmoidf_(float x) { return __builtin_amdgcn_rcpf(1.0f + __expf(-x)); }

constexpr int D = 1024, BATCH = 8, SEQ = 4096, NMETA = 16;
constexpr int MTOK = BATCH * SEQ;
constexpr int MPAD = MTOK + 256;
constexpr int S5W = 512, S5G = 32, S5C = 16, S5P = 64;
constexpr int NH = 8, HD = 64, VD = 128;
constexpr int DFF = 4096;
constexpr int TCH = 32, NCH = SEQ / TCH;
constexpr int KY = TCH * S5C + 4 * S5P;
constexpr float EPS = 1e-6f;
constexpr float LOG2E = 1.4426950408889634f;
constexpr float QSCALE = 0.125f * LOG2E;
constexpr int NLUT = 183;
constexpr int NLUT2 = 384, LUT2_OFF = 8 * 183 + 8;

constexpr size_t MiB = 1u << 20;
constexpr size_t WS_XB = 0;
constexpr size_t WS_SLOC = 0;
constexpr size_t WS_GY = 32 * MiB;
constexpr size_t WS_QO = 65 * MiB;
constexpr size_t WS_KIMG = 129 * MiB;
constexpr size_t WS_VIMG = 193 * MiB;
constexpr size_t WS_KMETA = 257 * MiB;
constexpr size_t WS_VMETA = 257 * MiB + 128 * 1024;
constexpr size_t WS_HBUF = 0;
constexpr size_t WS_G1 = 258 * MiB;
constexpr size_t WS_G2 = 322 * MiB;
constexpr size_t WS_MGT = 386 * MiB;
constexpr size_t WS_UGS = 410 * MiB;
constexpr size_t WS_WSTT = 458 * MiB;
constexpr size_t WS_H1B = 386 * MiB;
constexpr size_t WS_WIN = 466 * MiB;
constexpr size_t WS_WGLU = 477 * MiB;
constexpr size_t WS_WAO = 479 * MiB;
constexpr size_t WS_WWO = 481 * MiB;
constexpr size_t WS_WF1 = 483 * MiB;
constexpr size_t WS_WF2 = 491 * MiB;
constexpr size_t WS_RSTD1 = 499 * MiB;
constexpr size_t WS_SS = WS_RSTD1 + 256 * 1024;
constexpr size_t WS_LUT = WS_SS + 2 * MiB;
constexpr size_t WS_UMETA = WS_LUT + 32 * 1024;
constexpr size_t WS_CTL = WS_UMETA + 32 * 1024;
constexpr size_t CTL_BYTES = 32 * 1024;
constexpr size_t WS_END = WS_CTL + CTL_BYTES;

namespace pg8 {
constexpr int BM = 256, BK = 64, HALF = 128, HTB = HALF * BK * 2, STAGE_BYTES = 8 * HTB, NXCD = 8, WGM = 8;
__host__ __device__ __forceinline__ int lds_byte(int r, int c) { const int st = (r >> 4) * 2 + (c >> 5), rr = r & 15, cc = c & 31, ob = rr * 64 + cc * 2; return st * 1024 + (ob ^ (((ob >> 9) & 1) << 5)); }
__host__ __device__ __forceinline__ void stage_rc(int b, int& R, int& C) { const int st = b / 1024, sb = b % 1024, swz = sb ^ (((sb >> 9) & 1) << 5); R = (st >> 1) * 16 + swz / 64; C = (st & 1) * 32 + (swz % 64) / 2; }
__host__ __device__ __forceinline__ int perm32(int rho) { const int n = rho >> 4, i = rho & 15; return 8 * (i >> 2) + 4 * n + (i & 3); }

struct Unit { int pm, pn; };
struct Gemm { const bf16_t* A; const bf16_t* Bt; int lda, ldb, K; };

struct StaticOrder {
    int nM, nN, nwg, G, c;
    __device__ void init(int nM_, int nN_, int G_, int c_) { nM = nM_; nN = nN_; nwg = nM * nN; G = G_; c = c_; }
    __device__ bool next(int i, Unit& u) const {
        const long L = (long)i * G + c; if (L >= nwg) return false;
        int wgid = (int)L; { const int q = nwg / NXCD, r = nwg % NXCD, xcd = wgid % NXCD, off = wgid / NXCD; wgid = (xcd < r ? xcd * (q + 1) : r * (q + 1) + (xcd - r) * q) + off; }
        const int nig = WGM * nN, gid = wgid / nig, fm = gid * WGM, gsz = (nM - fm) < WGM ? (nM - fm) : WGM;
        u.pm = fm + ((wgid % nig) % gsz); u.pn = (wgid % nig) / gsz; return true;
    }
};
struct PanelOrder {
    int pm, nN, G, c;
    __device__ bool next(int i, Unit& u) const { const int L = i * G + c; if (L >= nN) return false; u.pm = pm; u.pn = L; return true; }
};
template <int RM, int CN> struct GroupOrder {
    int G, c;
    __device__ bool next(int i, Unit& u) const {
        const int L = i * G + c; if (L >= 32 * RM * CN) return false;
        const int g = L / (RM * CN), r = L % (RM * CN);
        u.pm = g * RM + r / CN; u.pn = g * CN + r % CN; return true;
    }
};

template <class Epi, class Sched, bool SWAP>
__device__ __forceinline__ void gemm_phase(LAS unsigned char* lds, const Gemm g, const Sched& S, const Epi& E) {
    int tid = threadIdx.x; asm volatile("" : "+v"(tid));
    const int wid = __builtin_amdgcn_readfirstlane(tid >> 6), lane = tid & 63, wr = wid >> 2, wc = wid & 3, fr = lane & 15, fq = lane >> 4;
    const int K = g.K, nt = K / BK;
    unsigned voffA[2], voffB[2];
#pragma unroll
    for (int i = 0; i < 2; ++i) { int R, C; stage_rc(tid * 16 + i * 8192, R, C); const int Rb = Epi::PERM ? ((R & ~31) + perm32(R & 31)) : R;
        voffA[i] = (unsigned)(R * g.lda + C) * 2u; voffB[i] = (unsigned)(Rb * g.ldb + C) * 2u; }
    const size_t kstep = (size_t)(BK * 2);
    const size_t hstepA = (size_t)HALF * g.lda * 2, hstepB = (size_t)HALF * g.ldb * 2;
    const size_t tstepA = 2 * hstepA, tstepB = 2 * hstepB;
    const unsigned ldsw = (unsigned)wid * 1024u;
    const int aoff = lds_byte(wr * 64 + fr, fq * 8), boff = lds_byte(wc * 32 + fr, fq * 8);
#define PG8_SA(b, h) (((b) * 2 + (h)) * HTB)
#define PG8_SB(b, h) ((4 + (b) * 2 + (h)) * HTB)
#define PG8_STAGE(bufoff, gbase, voff) do { _Pragma("unroll") for (int _i = 0; _i < 2; ++_i) \
        __builtin_amdgcn_global_load_lds((const unsigned*)((const char*)(gbase) + (voff)[_i]), (LAS unsigned*)(lds + (bufoff) + ldsw + _i * 8192), 16, 0, 0); } while (0)
#define PG8_LDA(dst, b, h) do { _Pragma("unroll") for (int m = 0; m < 4; ++m) _Pragma("unroll") for (int k = 0; k < 2; ++k) dst[m][k] = *(const LAS bf16x8*)(lds + PG8_SA(b, h) + aoff + m * 2048 + k * 1024); } while (0)
#define PG8_LDB(dst, b, h) do { _Pragma("unroll") for (int n = 0; n < 2; ++n) _Pragma("unroll") for (int k = 0; k < 2; ++k) dst[n][k] = *(const LAS bf16x8*)(lds + PG8_SB(b, h) + boff + n * 2048 + k * 1024); } while (0)
#define PG8_MMA(ai, bj, At, Bt) do { __builtin_amdgcn_s_setprio(1); _Pragma("unroll") for (int m = 0; m < 4; ++m) _Pragma("unroll") for (int n = 0; n < 2; ++n) _Pragma("unroll") for (int k = 0; k < 2; ++k) \
        acc[ai][bj][m][n] = SWAP ? __builtin_amdgcn_mfma_f32_16x16x32_bf16(At[m][k], Bt[n][k], acc[ai][bj][m][n], 0, 0, 0) \
                                 : __builtin_amdgcn_mfma_f32_16x16x32_bf16(Bt[n][k], At[m][k], acc[ai][bj][m][n], 0, 0, 0); __builtin_amdgcn_s_setprio(0); } while (0)
#define PG8_WAIT_V(n) asm volatile("s_waitcnt vmcnt(" #n ")" ::: "memory")
#define PG8_WAIT_L(n) asm volatile("s_waitcnt lgkmcnt(" #n ")" ::: "memory")
#define PG8_BAR __builtin_amdgcn_s_barrier()
#define PG8_SCHED __builtin_amdgcn_sched_barrier(0)
    Unit cur, nxt; int ui = 0;
    if (!S.next(0, cur)) return;
    f32x4 acc[2][2][4][2];
#pragma unroll
    for (int a = 0; a < 2; ++a)
#pragma unroll
        for (int b = 0; b < 2; ++b)
#pragma unroll
            for (int m = 0; m < 4; ++m)
#pragma unroll
                for (int n = 0; n < 2; ++n) acc[a][b][m][n] = (f32x4){0.f, 0.f, 0.f, 0.f};
    bf16x8 At[4][2], B0[2][2], B1[2][2];
    const char* cA = (const char*)g.A + (size_t)cur.pm * tstepA; const char* cB = (const char*)g.Bt + (size_t)cur.pn * tstepB;
    PG8_STAGE(PG8_SB(0, 0), cB, voffB); PG8_STAGE(PG8_SB(0, 1), cB + hstepB, voffB); PG8_STAGE(PG8_SA(0, 0), cA, voffA); PG8_STAGE(PG8_SA(0, 1), cA + hstepA, voffA);
    if (wr == 1) PG8_BAR;
    PG8_WAIT_V(2); PG8_BAR;
    PG8_STAGE(PG8_SB(1, 0), cB + kstep, voffB); PG8_STAGE(PG8_SA(1, 0), cA + kstep, voffA); PG8_STAGE(PG8_SB(1, 1), cB + hstepB + kstep, voffB);
    PG8_WAIT_V(6); PG8_BAR;
    for (;;) {
        const bool has_next = S.next(ui + 1, nxt);
        const char* nA = has_next ? (const char*)g.A + (size_t)nxt.pm * tstepA : cA; const char* nB = has_next ? (const char*)g.Bt + (size_t)nxt.pn * tstepB : cB;
        for (int t = 0; t < nt; t += 2) {
            const bool last = (t == nt - 2);
            const char* a1 = cA + (size_t)(t + 1) * kstep;
            const char* a2 = last ? nA : cA + (size_t)(t + 2) * kstep; const char* b2 = last ? nB : cB + (size_t)(t + 2) * kstep;
            const char* a3 = a2 + kstep; const char* b3 = b2 + kstep;
            PG8_LDB(B0, 0, 0); PG8_LDB(B1, 0, 1); PG8_SCHED; PG8_LDA(At, 0, 0); PG8_STAGE(PG8_SA(1, 1), a1 + hstepA, voffA);
            PG8_WAIT_V(8); PG8_WAIT_L(0); PG8_BAR; PG8_MMA(0, 0, At, B0); PG8_MMA(0, 1, At, B1); PG8_BAR; PG8_SCHED;
            PG8_LDA(At, 0, 1); PG8_STAGE(PG8_SB(0, 0), b2, voffB); PG8_STAGE(PG8_SB(0, 1), b2 + hstepB, voffB); PG8_STAGE(PG8_SA(0, 0), a2, voffA);
            PG8_WAIT_V(8); PG8_WAIT_L(0); PG8_BAR; PG8_MMA(1, 0, At, B0); PG8_MMA(1, 1, At, B1); PG8_BAR; PG8_SCHED;
            PG8_LDB(B0, 1, 0); PG8_LDB(B1, 1, 1); PG8_SCHED; PG8_LDA(At, 1, 0); PG8_STAGE(PG8_SA(0, 1), a2 + hstepA, voffA);
            PG8_WAIT_V(8); PG8_WAIT_L(0); PG8_BAR; PG8_MMA(0, 0, At, B0); PG8_MMA(0, 1, At, B1); PG8_BAR; PG8_SCHED;
            PG8_LDA(At, 1, 1); PG8_STAGE(PG8_SB(1, 0), b3, voffB); PG8_STAGE(PG8_SB(1, 1), b3 + hstepB, voffB); PG8_STAGE(PG8_SA(1, 0), a3, voffA);
            PG8_WAIT_V(8); PG8_WAIT_L(0); PG8_BAR; PG8_MMA(1, 0, At, B0); PG8_MMA(1, 1, At, B1); PG8_BAR; PG8_SCHED;
        }
        if (wr == 0) PG8_BAR;
        { int le = lane; asm volatile("" : "+v"(le)); E(acc, cur, wr, wc, le & 15, le >> 4); }
        if (!has_next) break;
#pragma unroll
        for (int a = 0; a < 2; ++a)
#pragma unroll
            for (int b = 0; b < 2; ++b)
#pragma unroll
                for (int m = 0; m < 4; ++m)
#pragma unroll
                    for (int n = 0; n < 2; ++n) acc[a][b][m][n] = (f32x4){0.f, 0.f, 0.f, 0.f};
        cur = nxt; cA = nA; cB = nB; ++ui;
        if (wr == 1) PG8_BAR;
    }
    PG8_WAIT_V(0);
    PG8_BAR;
#undef PG8_SA
#undef PG8_SB
#undef PG8_STAGE
#undef PG8_LDA
#undef PG8_LDB
#undef PG8_MMA
#undef PG8_WAIT_V
#undef PG8_WAIT_L
#undef PG8_BAR
#undef PG8_SCHED
}
}
using pg8::Unit;

__device__ __forceinline__ int pi_slot(int k) { return (k & ~12) | ((k & 4) << 1) | ((k & 8) >> 1); }
__device__ __forceinline__ u32x4 pack8(const f32x4 a, const f32x4 b) { u32x4 w; w.x = cvtpk(a[0], a[1]); w.y = cvtpk(a[2], a[3]); w.z = cvtpk(b[0], b[1]); w.w = cvtpk(b[2], b[3]); return w; }

__device__ __forceinline__ float bflo(unsigned w) { return __uint_as_float(w << 16); }
__device__ __forceinline__ float bfhi(unsigned w) { return __uint_as_float(w & 0xffff0000u); }
struct EpiInMain {
    static constexpr bool PERM = true;
    const float* rstd1; bf16_t* ugs; float* umeta; bf16_t* qbuf; bf16_t* kimg; bf16_t* kmeta; bf16_t* g1; bf16_t* g2; const float* qn; const float* kn;
    __device__ __forceinline__ void operator()(const f32x4 (&acc)[2][2][4][2], const Unit& u, int wr, int wc, int fr, int fq) const {
        const int pn = u.pn, pm = u.pm; const bool meta = (pm == MTOK / 256);
        const int b = pm >> 4;
        f32x4 gw[2][2];
        { const float* gp = (pn < 6) ? qn : kn; const float sc = (pn < 6) ? QSCALE : 1.0f;
#pragma unroll
          for (int bj = 0; bj < 2; ++bj)
#pragma unroll
              for (int n = 0; n < 2; ++n) gw[bj][n] = (pn >= 2 && pn < 10) ? *(const f32x4*)(gp + 32 * bj + 8 * fq + 4 * n) * sc : (f32x4){1.f, 1.f, 1.f, 1.f}; }
#pragma unroll
        for (int ai = 0; ai < 2; ++ai)
#pragma unroll
            for (int m = 0; m < 4; ++m) {
                const int rloc = ai * 128 + wr * 64 + m * 16 + fr;
                const int r = pm * 256 + rloc;
                const int j = (pm & 15) * 256 + rloc;
                f32x4 v[2][2];
#pragma unroll
                for (int bj = 0; bj < 2; ++bj)
#pragma unroll
                    for (int n = 0; n < 2; ++n) v[bj][n] = acc[ai][bj][m][n];
                if (pn < 2) {
#pragma unroll
                    for (int bj = 0; bj < 2; ++bj) {
                        const int c = 256 * pn + 64 * wc + 32 * bj + 8 * fq;
                        if (!meta) { const int gg = c >> 4, c0 = c & 15;
                            bf16_t* dst = ugs + ((size_t)gg * (BATCH * NCH) + b * NCH + (j >> 5)) * KY + (j & 31) * 16 + c0;
                            *(u32x4*)dst = pack8(v[bj][0], v[bj][1]);
                        } else if (rloc < NMETA) { float* dst = umeta + rloc * S5W + c; *(f32x4*)dst = v[bj][0]; *(f32x4*)(dst + 4) = v[bj][1]; }
                    }
                } else if (pn < 10) {
                    float ss = 0.f;
#pragma unroll
                    for (int bj = 0; bj < 2; ++bj)
#pragma unroll
                        for (int n = 0; n < 2; ++n) { const f32x4 x = v[bj][n]; ss += (x[0] * x[0] + x[1] * x[1]) + (x[2] * x[2] + x[3] * x[3]); }
                    ss += __shfl_xor(ss, 16); ss += __shfl_xor(ss, 32);
                    const float sc = rsqrtf(ss * (1.0f / 64.0f) + EPS);
#pragma unroll
                    for (int bj = 0; bj < 2; ++bj) {
                        const f32x4 o0 = v[bj][0] * gw[bj][0] * sc, o1 = v[bj][1] * gw[bj][1] * sc;
                        const u32x4 w = pack8(o0, o1);
                        if (pn < 6) { if (!meta) { const int cq = 256 * (pn - 2) + 64 * wc + 32 * bj + 8 * fq; *(u32x4*)(qbuf + (size_t)r * 1024 + cq) = w; } }
                        else { const int h = 2 * (pn - 6) + (wc >> 1), chunk = 8 * (wc & 1) + 4 * bj + fq;
                            if (!meta) { const int tile = j >> 6, slot = pi_slot(j & 63);
                                *(u32x4*)(kimg + ((((size_t)(b * NH + h) * 64 + tile) * 16 + chunk) * 64 + slot) * 8) = w;
                            } else if (rloc < 64) { *(u32x4*)(kmeta + (((size_t)h * 16 + chunk) * 64 + pi_slot(rloc)) * 8) = w; } }
                    }
                } else {
                    if (!meta) { bf16_t* gb = (pn < 14) ? g1 : g2; const int pg = (pn < 14) ? pn - 10 : pn - 14;
#pragma unroll
                        for (int bj = 0; bj < 2; ++bj) { f32x4 o0, o1;
#pragma unroll
                            for (int i = 0; i < 4; ++i) { o0[i] = sigmoidf_(v[bj][0][i]); o1[i] = sigmoidf_(v[bj][1][i]); }
                            *(u32x4*)(gb + (size_t)r * 1024 + 256 * pg + 64 * wc + 32 * bj + 8 * fq) = pack8(o0, o1); } }
                }
            }
    }
};
struct EpiInV {
    static constexpr bool PERM = false;
    const float* rstd1; bf16_t* vimg; bf16_t* vmeta;
    __device__ __forceinline__ void operator()(const f32x4 (&acc)[2][2][4][2], const Unit& u, int wr, int wc, int fr, int fq) const {
        const int pn = u.pn, pm = u.pm; const bool meta = (pm == MTOK / 256); const int b = pm >> 4;
#pragma unroll
        for (int ai = 0; ai < 2; ++ai) {
            if (meta && (ai | wr)) continue;
            const int tile = (pm & 15) * 4 + 2 * ai + wr;
#pragma unroll
            for (int m = 0; m < 4; ++m) {
                const int kvchunk = 2 * m + (fq >> 1), within = 4 * (fq & 1);
#pragma unroll
                for (int bj = 0; bj < 2; ++bj)
#pragma unroll
                    for (int n = 0; n < 2; ++n) {
                        const int h = 2 * pn + bj, e = 32 * wc + 16 * n + fr;
                        const f32x4 x = acc[ai][bj][m][n];
                        u32x2 w; w.x = cvtpk(x[0], x[1]); w.y = cvtpk(x[2], x[3]);
                        bf16_t* dst = meta ? vmeta + (((size_t)h * 8 + kvchunk) * 128 + e) * 8 + within
                                           : vimg + ((((size_t)(b * NH + h) * 64 + tile) * 8 + kvchunk) * 128 + e) * 8 + within;
                        *(u32x2*)dst = w;
                    }
            }
        }
    }
};
struct EpiSloc {
    static constexpr bool PERM = true;
    float* sloc;
    __device__ __forceinline__ void operator()(const f32x4 (&acc)[2][2][4][2], const Unit& u, int wr, int wc, int fr, int fq) const {
#pragma unroll
        for (int ai = 0; ai < 2; ++ai)
#pragma unroll
            for (int m = 0; m < 4; ++m) { const int r = u.pm * 256 + ai * 128 + wr * 64 + m * 16 + fr;
#pragma unroll
                for (int bj = 0; bj < 2; ++bj) { float* dst = sloc + (size_t)r * 256 + 128 * bj + 32 * wc + 8 * fq;
                    *(f32x4*)dst = acc[ai][bj][m][0]; *(f32x4*)(dst + 4) = acc[ai][bj][m][1]; } }
    }
};
__device__ __forceinline__ float gelu_tanh(float x) { const float u = 0.7978845608028654f * (x + 0.044715f * x * x * x); return x * __builtin_amdgcn_rcpf(1.0f + __expf(-2.0f * u)); }
struct EpiY {
    static constexpr bool PERM = true;
    bf16_t* gy;
    __device__ __forceinline__ void operator()(const f32x4 (&acc)[2][2][4][2], const Unit& u, int wr, int wc, int fr, int fq) const {
        const int g = u.pm >> 2;
#pragma unroll
        for (int ai = 0; ai < 2; ++ai)
#pragma unroll
            for (int m = 0; m < 4; ++m) { const int rg = (u.pm & 3) * 256 + ai * 128 + wr * 64 + m * 16 + fr;
                const int b = rg >> 7, ch = rg & 127;
#pragma unroll
                for (int bj = 0; bj < 2; ++bj) { const int n0 = 256 * (u.pn & 1) + 128 * bj + 32 * wc + 8 * fq; const int tp = n0 >> 4, c0 = n0 & 15;
                    f32x4 o0, o1;
#pragma unroll
                    for (int i = 0; i < 4; ++i) { o0[i] = gelu_tanh(acc[ai][bj][m][0][i]); o1[i] = gelu_tanh(acc[ai][bj][m][1][i]); }
                    *(u32x4*)(gy + ((size_t)b * SEQ + ch * TCH + tp) * S5W + g * 16 + c0) = pack8(o0, o1); } }
    }
};
struct EpiGlu {
    static constexpr bool PERM = true;
    bf16_t* g1; int dry;
    __device__ __forceinline__ void operator()(const f32x4 (&acc)[2][2][4][2], const Unit& u, int wr, int wc, int fr, int fq) const {
        u32x4 gv[2][4];
#pragma unroll
        for (int ai = 0; ai < 2; ++ai)
#pragma unroll
            for (int m = 0; m < 4; ++m) gv[ai][m] = *(const u32x4*)(g1 + (size_t)(u.pm * 256 + ai * 128 + wr * 64 + m * 16 + fr) * 1024 + 128 * u.pn + 32 * wc + 8 * fq);
#pragma unroll
        for (int ai = 0; ai < 2; ++ai)
#pragma unroll
            for (int m = 0; m < 4; ++m) { const int r = u.pm * 256 + ai * 128 + wr * 64 + m * 16 + fr;
                bf16_t* p = g1 + (size_t)r * 1024 + 128 * u.pn + 32 * wc + 8 * fq;
                const u32x4 g = gv[ai][m]; f32x4 o0, o1;
#pragma unroll
                for (int i = 0; i < 4; ++i) {
                    const float ga = (i & 1) ? bfhi(g[i >> 1]) : bflo(g[i >> 1]), gb = (i & 1) ? bfhi(g[2 + (i >> 1)]) : bflo(g[2 + (i >> 1)]);
                    o0[i] = acc[ai][0][m][0][i] * sigmoidf_(acc[ai][1][m][0][i]) * ga;
                    o1[i] = acc[ai][0][m][1][i] * sigmoidf_(acc[ai][1][m][1][i]) * gb; }
                if (!dry) *(u32x4*)p = pack8(o0, o1); }
    }
};
struct EpiAo {
    static constexpr bool PERM = true;
    const bf16_t* t2; bf16_t* g2; int dry;
    __device__ __forceinline__ void operator()(const f32x4 (&acc)[2][2][4][2], const Unit& u, int wr, int wc, int fr, int fq) const {
        u32x4 gv[2][2][2], tv[2][2][2];
#define AO_OFF(q, mm, bj) ((size_t)(u.pm * 256 + ((q) >> 1) * 128 + wr * 64 + (((q) & 1) * 2 + (mm)) * 16 + fr) * 1024 + 256 * u.pn + 128 * (bj) + 32 * wc + 8 * fq)
#define AO_LOAD(buf, q) do { _Pragma("unroll") for (int mm = 0; mm < 2; ++mm) _Pragma("unroll") for (int bj = 0; bj < 2; ++bj) { \
            gv[buf][mm][bj] = *(const u32x4*)(g2 + AO_OFF(q, mm, bj)); tv[buf][mm][bj] = *(const u32x4*)(t2 + AO_OFF(q, mm, bj)); } } while (0)
        AO_LOAD(0, 0);
#pragma unroll
        for (int q = 0; q < 4; ++q) {
            if (q + 1 < 4) { if (q & 1) AO_LOAD(0, q + 1); else AO_LOAD(1, q + 1); }
#pragma unroll
            for (int mm = 0; mm < 2; ++mm)
#pragma unroll
                for (int bj = 0; bj < 2; ++bj) { const u32x4 g = gv[q & 1][mm][bj], t = tv[q & 1][mm][bj]; const int ai = q >> 1, m = (q & 1) * 2 + mm; f32x4 o0, o1;
#pragma unroll
                    for (int i = 0; i < 4; ++i) {
                        const float ga = (i & 1) ? bfhi(g[i >> 1]) : bflo(g[i >> 1]), gb = (i & 1) ? bfhi(g[2 + (i >> 1)]) : bflo(g[2 + (i >> 1)]);
                        const float ta = (i & 1) ? bfhi(t[i >> 1]) : bflo(t[i >> 1]), tb = (i & 1) ? bfhi(t[2 + (i >> 1)]) : bflo(t[2 + (i >> 1)]);
                        o0[i] = ta + ga * acc[ai][bj][m][0][i]; o1[i] = tb + gb * acc[ai][bj][m][1][i]; }
                    if (!dry) *(u32x4*)(g2 + AO_OFF(q, mm, bj)) = pack8(o0, o1); }
        }
#undef AO_LOAD
#undef AO_OFF
    }
};
struct EpiWo {
    static constexpr bool PERM = false;
    const float* x; float* out; bf16_t* h1b; float* ss; int dry;
    __device__ __forceinline__ void operator()(const f32x4 (&acc)[2][2][4][2], const Unit& u, int wr, int wc, int fr, int fq) const {
        f32x4 xv[2][2][2][2];
#define WO_OFF(q, mm, bj, n) ((size_t)(u.pm * 256 + ((q) >> 1) * 128 + wr * 64 + (((q) & 1) * 2 + (mm)) * 16 + fr) * 1024 + 256 * u.pn + 128 * (bj) + 32 * wc + 16 * (n) + 4 * fq)
#define WO_LOAD(buf, q) do { _Pragma("unroll") for (int mm = 0; mm < 2; ++mm) _Pragma("unroll") for (int bj = 0; bj < 2; ++bj) _Pragma("unroll") for (int n = 0; n < 2; ++n) \
            xv[buf][mm][bj][n] = *(const f32x4*)(x + WO_OFF(q, mm, bj, n)); } while (0)
        WO_LOAD(0, 0);
#pragma unroll
        for (int q = 0; q < 4; ++q) {
            if (q + 1 < 4) { if (q & 1) WO_LOAD(0, q + 1); else WO_LOAD(1, q + 1); }
#pragma unroll
            for (int mm = 0; mm < 2; ++mm) { const int ai = q >> 1, m = (q & 1) * 2 + mm; const int r = u.pm * 256 + ai * 128 + wr * 64 + m * 16 + fr; float sq = 0.f;
#pragma unroll
                for (int bj = 0; bj < 2; ++bj)
#pragma unroll
                    for (int n = 0; n < 2; ++n) { const size_t off = WO_OFF(q, mm, bj, n);
                        const f32x4 h = xv[q & 1][mm][bj][n] + acc[ai][bj][m][n];
                        u32x2 w; w.x = cvtpk(h[0], h[1]); w.y = cvtpk(h[2], h[3]); if (!dry) *(u32x2*)(h1b + off) = w;
                        sq += (h[0] * h[0] + h[1] * h[1]) + (h[2] * h[2] + h[3] * h[3]); }
                sq += __shfl_xor(sq, 16); sq += __shfl_xor(sq, 32);
                if (fq == 0) ss[(size_t)r * 16 + u.pn * 4 + wc] = sq; }
        }
#undef WO_LOAD
#undef WO_OFF
    }
};
struct EpiF1 {
    static constexpr bool PERM = true;
    const float* ss; bf16_t* hb;
    __device__ __forceinline__ void operator()(const f32x4 (&acc)[2][2][4][2], const Unit& u, int wr, int wc, int fr, int fq) const {
        float rsv[2][4];
#pragma unroll
        for (int ai = 0; ai < 2; ++ai) { f32x4 sv[4][4];
#pragma unroll
            for (int m = 0; m < 4; ++m) { const f32x4* sp = (const f32x4*)(ss + (size_t)(u.pm * 256 + ai * 128 + wr * 64 + m * 16 + fr) * 16);
#pragma unroll
                for (int k = 0; k < 4; ++k) sv[m][k] = sp[k]; }
#pragma unroll
            for (int m = 0; m < 4; ++m) { float tot = 0.f;
#pragma unroll
                for (int k = 0; k < 4; ++k) tot += (sv[m][k][0] + sv[m][k][1]) + (sv[m][k][2] + sv[m][k][3]);
                rsv[ai][m] = rsqrtf(tot * (1.0f / 1024.0f) + EPS); } }
#pragma unroll
        for (int ai = 0; ai < 2; ++ai)
#pragma unroll
            for (int m = 0; m < 4; ++m) { const int r = u.pm * 256 + ai * 128 + wr * 64 + m * 16 + fr; const float rs = rsv[ai][m];
#pragma unroll
                for (int bj = 0; bj < 2; ++bj) { f32x4 o0, o1;
#pragma unroll
                    for (int i = 0; i < 4; ++i) { const float a0 = fmaxf(acc[ai][bj][m][0][i] * rs, 0.f), a1 = fmaxf(acc[ai][bj][m][1][i] * rs, 0.f); o0[i] = a0 * a0; o1[i] = a1 * a1; }
                    *(u32x4*)(hb + (size_t)r * DFF + 256 * u.pn + 64 * wc + 32 * bj + 8 * fq) = pack8(o0, o1); } }
    }
};
struct EpiF2 {
    static constexpr bool PERM = false;
    const bf16_t* h1b; float* out; int dry;
    __device__ __forceinline__ void operator()(const f32x4 (&acc)[2][2][4][2], const Unit& u, int wr, int wc, int fr, int fq) const {
        u32x2 xv[2][2][2][2];
#define F2_OFF(q, mm, bj, n) ((size_t)(u.pm * 256 + ((q) >> 1) * 128 + wr * 64 + (((q) & 1) * 2 + (mm)) * 16 + fr) * 1024 + 256 * u.pn + 128 * (bj) + 32 * wc + 16 * (n) + 4 * fq)
#define F2_LOAD(buf, q) do { _Pragma("unroll") for (int mm = 0; mm < 2; ++mm) _Pragma("unroll") for (int bj = 0; bj < 2; ++bj) _Pragma("unroll") for (int n = 0; n < 2; ++n) \
            xv[buf][mm][bj][n] = *(const u32x2*)(h1b + F2_OFF(q, mm, bj, n)); } while (0)
        F2_LOAD(0, 0);
#pragma unroll
        for (int q = 0; q < 4; ++q) {
            if (q + 1 < 4) { if (q & 1) F2_LOAD(0, q + 1); else F2_LOAD(1, q + 1); }
#pragma unroll
            for (int mm = 0; mm < 2; ++mm) { const int ai = q >> 1, m = (q & 1) * 2 + mm;
#pragma unroll
                for (int bj = 0; bj < 2; ++bj)
#pragma unroll
                    for (int n = 0; n < 2; ++n) { const u32x2 w = xv[q & 1][mm][bj][n]; const f32x4 h = {bflo(w.x), bfhi(w.x), bflo(w.y), bfhi(w.y)};
                        const f32x4 v = h + acc[ai][bj][m][n]; if (!dry) *(f32x4*)(out + F2_OFF(q, mm, bj, n)) = v; } }
        }
#undef F2_LOAD
#undef F2_OFF
    }
};

__device__ __forceinline__ int crow(int r, int hi) { return (r & 3) + 8 * (r >> 2) + 4 * hi; }
template <bool WITH_PV, int VAR = 0>
__device__ __forceinline__ void attn_ab(const LAS unsigned char* kb, const LAS unsigned char* vb, const bf16x8 (&qf)[4], const u32x4 (&pwc)[4], u32x4 (&pwn)[4], f32x16 (&o)[4], float& l,
                                        bool slow, float rho, int relb, int nvalid, const LAS float* lut, const LAS float* lut2, int i32, int hi) {
#define AB_PIN() __builtin_amdgcn_sched_barrier(0)
    bf16x8 kf[8], vf[2][4];
#pragma unroll
    for (int ds = 0; ds < 4; ++ds) {
        if (VAR & 16) { asm volatile("" : "=v"(kf[2 * ds])); asm volatile("" : "=v"(kf[2 * ds + 1])); }
        else { kf[2 * ds] = *(const LAS bf16x8*)(kb + ((2 * ds + hi) * 64 + i32) * 16); kf[2 * ds + 1] = *(const LAS bf16x8*)(kb + ((2 * ds + hi) * 64 + 32 + i32) * 16); } }
    if (WITH_PV) {
#pragma unroll
        for (int eb = 0; eb < 4; ++eb) { if (VAR & 16) asm volatile("" : "=v"(vf[0][eb])); else vf[0][eb] = *(const LAS bf16x8*)(vb + ((0 + hi) * 128 + 32 * eb + i32) * 16); }
    }
    AB_PIN();
    f32x16 s0, s1;
#pragma unroll
    for (int r = 0; r < 16; ++r) { s0[r] = 0.f; s1[r] = 0.f; }
#pragma unroll
    for (int ds = 0; ds < 4; ++ds) { if (VAR & 4) { asm volatile("" : "+v"(s0), "+v"(s1) : "v"(kf[2 * ds]), "v"(kf[2 * ds + 1])); } else {
        s0 = __builtin_amdgcn_mfma_f32_32x32x16_bf16(kf[2 * ds], qf[ds], s0, 0, 0, 0); s1 = __builtin_amdgcn_mfma_f32_32x32x16_bf16(kf[2 * ds + 1], qf[ds], s1, 0, 0, 0); } }
    AB_PIN();
    if (slow) {
        if (nvalid == 64) {
            const LAS float* lp = lut2 + (relb + 8 * hi - i32 + 185);
#pragma unroll
            for (int r = 0; r < 16; ++r) {
                const int kap = (r & 3) + 4 * ((r >> 2) & 1) + 16 * (r >> 3);
                s0[r] = (s0[r] + lp[kap]) - rho; s1[r] = (s1[r] + lp[kap + 32]) - rho;
            }
        } else {
            const int base = relb + 8 * hi - i32 + 91;
            const float ninf = -INFINITY;
#pragma unroll
            for (int r = 0; r < 16; ++r) {
                const int kap = (r & 3) + 4 * ((r >> 2) & 1) + 16 * (r >> 3);
                const int i0 = min(max(base + kap, 0), NLUT - 1), i1 = min(max(base + kap + 32, 0), NLUT - 1);
                const float m0 = (kap + 8 * hi < nvalid) ? -rho : ninf, m1 = (kap + 8 * hi + 32 < nvalid) ? -rho : ninf;
                s0[r] = (s0[r] + lut[i0]) + m0; s1[r] = (s1[r] + lut[i1]) + m1;
            }
        }
    }
    AB_PIN();
    float sum0 = 0.f, sum1 = 0.f;
#pragma unroll
    for (int sk = 0; sk < 4; ++sk) {
        if (WITH_PV && sk < 3) {
#pragma unroll
            for (int eb = 0; eb < 4; ++eb) { if (VAR & 16) asm volatile("" : "=v"(vf[(sk + 1) & 1][eb])); else vf[(sk + 1) & 1][eb] = *(const LAS bf16x8*)(vb + ((2 * (sk + 1) + hi) * 128 + 32 * eb + i32) * 16); }
            AB_PIN();
        }
#pragma unroll
        for (int eb = 0; eb < 4; ++eb) {
            const int m = 4 * sk + eb;
            if (WITH_PV) { if (VAR & 8) asm volatile("" : "+v"(o[eb]) : "v"(vf[sk & 1][eb]), "v"(pwc[sk])); else o[eb] = __builtin_amdgcn_mfma_f32_32x32x16_bf16(vf[sk & 1][eb], __builtin_bit_cast(bf16x8, pwc[sk]), o[eb], 0, 0, 0); }
            float x0, x1;
            if (VAR & 2) { if (m < 8) { x0 = s0[2 * m]; x1 = s0[2 * m + 1]; } else { x0 = s1[2 * m - 16]; x1 = s1[2 * m - 15]; } }
            else if (m < 8) { x0 = __builtin_amdgcn_exp2f(s0[2 * m]); x1 = __builtin_amdgcn_exp2f(s0[2 * m + 1]); }
            else { x0 = __builtin_amdgcn_exp2f(s1[2 * m - 16]); x1 = __builtin_amdgcn_exp2f(s1[2 * m - 15]); }
            sum0 += x0; sum1 += x1;
            pwn[m >> 2][m & 3] = cvtpk(x0, x1);
            asm volatile("" : "+v"(pwn[m >> 2][m & 3]), "+v"(sum0), "+v"(sum1));
            if (WITH_PV) AB_PIN();
        }
    }
    l += sum0 + sum1;
#undef AB_PIN
}
__device__ __forceinline__ void attn_pv(const LAS unsigned char* vb, const u32x4 (&pw)[4], f32x16 (&o)[4], int i32, int hi) {
    bf16x8 vf[2][4];
#pragma unroll
    for (int s_ = 0; s_ < 4; ++s_) {
#pragma unroll
        for (int eb = 0; eb < 4; ++eb) vf[s_ & 1][eb] = *(const LAS bf16x8*)(vb + ((2 * s_ + hi) * 128 + 32 * eb + i32) * 16);
#pragma unroll
        for (int eb = 0; eb < 4; ++eb) o[eb] = __builtin_amdgcn_mfma_f32_32x32x16_bf16(vf[s_ & 1][eb], __builtin_bit_cast(bf16x8, pw[s_]), o[eb], 0, 0, 0);
    }
}

constexpr int AT4_KB = 0, AT4_VB = 65536, AT4_LUT = 114688, AT4_CMB = 0;
template <int VAR>
__device__ __forceinline__ void attn_unit4(LAS unsigned char* lds, int bh, int qb, bf16_t* qo, const bf16_t* kimg, const bf16_t* vimg, const bf16_t* kmeta, const bf16_t* vmeta,
                                           const float* lutg, int dry) {
    const int tid = threadIdx.x; int lane = tid & 63; asm volatile("" : "+v"(lane));
    const int i32 = lane & 31, hi = lane >> 5; const int wid = __builtin_amdgcn_readfirstlane(tid >> 6);
    const int b = bh >> 3, h = bh & 7, t = wid >> 2, qblk = wid & 3;
    const int q0 = qb * 128 + qblk * 32;
    const float lam = lutg[NH * NLUT];
    LAS float* lut = (LAS float*)(lds + AT4_LUT); LAS float* lut2 = lut + 192;
    if (tid < NLUT) lut[tid] = lutg[h * NLUT + tid];
    if (tid < NLUT2) lut2[tid] = lutg[LUT2_OFF + h * NLUT2 + tid];
    const unsigned char* gsrc = (const unsigned char*)(t ? vimg : kimg) + (size_t)bh * 64 * 16384 + qblk * 4096 + lane * 16;
    const unsigned char* msrc = (const unsigned char*)(t ? vmeta : kmeta) + (size_t)h * 16384 + qblk * 4096 + lane * 16;
    const unsigned ldst = (unsigned)((t ? AT4_VB : AT4_KB) + qblk * 4096);
#define AT4_DMA(j, slot) do { if (VAR & 1) break; const unsigned char* s_ = ((j) < 64) ? gsrc + (size_t)(j) * 16384 : msrc; \
        _Pragma("unroll") for (int p_ = 0; p_ < 4; ++p_) __builtin_amdgcn_global_load_lds((const unsigned*)(s_ + p_ * 1024), (LAS unsigned*)(lds + ldst + (slot) * 16384 + p_ * 1024), 16, 0, 0); } while (0)
#define AT4_BAR() do { __builtin_amdgcn_sched_barrier(0); __builtin_amdgcn_s_barrier(); __builtin_amdgcn_sched_barrier(0); } while (0)
    if (t == 0) { AT4_DMA(0, 0); AT4_DMA(1, 1); AT4_DMA(2, 2); } else { AT4_DMA(0, 0); AT4_DMA(1, 1); }
    bf16x8 qf[4];
    { const bf16_t* qp = qo + ((size_t)b * SEQ + q0 + i32) * 1024 + h * 128 + t * 64 + hi * 8;
#pragma unroll
      for (int ds = 0; ds < 4; ++ds) qf[ds] = *(const bf16x8*)(qp + ds * 16); }
    f32x16 o[4];
#pragma unroll
    for (int eb = 0; eb < 4; ++eb)
#pragma unroll
        for (int r = 0; r < 16; ++r) o[eb][r] = 0.f;
    float l = 0.f;
    asm volatile("s_waitcnt vmcnt(0) lgkmcnt(0)" ::: "memory");
    AT4_BAR();
    const float cneg = lut[0], cpos = lut[NLUT - 1];
    const int js0 = (q0 + 122 + 63) >> 6, js = (js0 < 64) ? js0 : 1000;
    const float rho_meta = (js0 < 64) ? cpos : cneg;
    const float fsw = __builtin_amdgcn_exp2f(cneg - cpos);
    const float rho = cneg;
    if (t == 1) __builtin_amdgcn_s_setprio(1);
    u32x4 pwc[4], pwn[4];
#define AT4_SLOW(j_) (!((j_) < 64 && (64 * (j_) + 63 - q0 <= -91 || 64 * (j_) - (q0 + 31) >= 91)))
    attn_ab<false>(lds + AT4_KB + t * 8192, lds + AT4_VB, qf, pwn, pwc, o, l, AT4_SLOW(0), rho, -q0, 64, lut, lut2, i32, hi);
    int vs = 0, vs2 = 2;
#pragma nounroll
    for (int j = 0; j < 64; ++j) {
        if (t == 0) { if (j + 3 < 65) AT4_DMA(j + 3, (j + 3) & 3); } else { if (j + 2 < 65) AT4_DMA(j + 2, vs2); }
        if (j + 1 == js) l *= fsw;
        {
            const int j_ = j + 1;
            attn_ab<true, VAR>(lds + AT4_KB + (j_ & 3) * 16384 + t * 8192, lds + AT4_VB + vs * 16384, qf, pwc, pwn, o, l, AT4_SLOW(j_), (j_ < 64) ? cneg : rho_meta,
                          (j_ < 64) ? 64 * j_ - q0 : -NMETA - q0, (j_ < 64) ? 64 : NMETA, lut, lut2, i32, hi);
        }
        if (j + 1 == js) {
#pragma unroll
            for (int eb = 0; eb < 4; ++eb)
#pragma unroll
                for (int r = 0; r < 16; ++r) o[eb][r] *= fsw;
        }
        if ((t == 0) ? (j + 3 < 65) : (j + 2 < 65)) asm volatile("s_waitcnt vmcnt(4)" ::: "memory"); else asm volatile("s_waitcnt vmcnt(0)" ::: "memory");
        if (!(VAR & 32)) AT4_BAR();
#pragma unroll
        for (int s_ = 0; s_ < 4; ++s_) pwc[s_] = pwn[s_];
        vs = (vs == 2) ? 0 : vs + 1; vs2 = (vs2 == 2) ? 0 : vs2 + 1;
    }
    attn_pv(lds + AT4_VB + vs * 16384, pwc, o, i32, hi);
    AT4_BAR();
    __builtin_amdgcn_s_setprio(0);
#undef AT4_SLOW
#undef AT4_DMA
    const float lt = l + __shfl_xor(l, 32);
    LAS float* cmb = (LAS float*)(lds + AT4_CMB) + qblk * 4096 + lane;
    if (t == 1) { const float sc = lam / lt;
#pragma unroll
        for (int eb = 0; eb < 4; ++eb)
#pragma unroll
            for (int r = 0; r < 16; ++r) cmb[(eb * 16 + r) * 64] = o[eb][r] * sc; }
    asm volatile("s_waitcnt lgkmcnt(0)" ::: "memory");
    AT4_BAR();
    if (t == 0) { const float sc = 1.0f / lt; float ssq = 0.f;
#pragma unroll
        for (int eb = 0; eb < 4; ++eb)
#pragma unroll
            for (int r = 0; r < 16; ++r) { const float v = o[eb][r] * sc - cmb[(eb * 16 + r) * 64]; o[eb][r] = v; ssq += v * v; }
        ssq += __shfl_xor(ssq, 32);
        const float rs = rsqrtf(ssq * (1.0f / 128.0f) + EPS);
        bf16_t* op = qo + ((size_t)b * SEQ + q0 + i32) * 1024 + h * 128 + 4 * hi;
        if (!dry) {
#pragma unroll
        for (int eb = 0; eb < 4; ++eb)
#pragma unroll
            for (int g = 0; g < 4; ++g) { u32x2 w; w.x = cvtpk(o[eb][4 * g] * rs, o[eb][4 * g + 1] * rs); w.y = cvtpk(o[eb][4 * g + 2] * rs, o[eb][4 * g + 3] * rs);
                *(u32x2*)(op + 32 * eb + 8 * g) = w; }
        }
    }
    asm volatile("s_waitcnt lgkmcnt(0)" ::: "memory");
    AT4_BAR();
#undef AT4_BAR
}

template <bool WITH_PV, int VAR = 0>
__device__ __forceinline__ void attn_ab7(bf16x8 (&kf)[8], bf16x8 (&vf0)[4], const LAS unsigned char* kbc, const LAS unsigned char* kbn, const LAS unsigned char* vb, const LAS unsigned char* vbn,
                                         const bf16x8 (&qf)[4], const u32x4 (&pwc)[4], u32x4 (&pwn)[4], f32x16 (&o)[4], float& l,
                                         bool slow, float rho, int relb, int nvalid, const LAS float* lut, const LAS float* lut2, int i32, int hi,
                                         __amdgpu_buffer_rsrc_t drs, int dvoff, int dsoff, LAS unsigned char* ddst) {
#define AB_PIN() __builtin_amdgcn_sched_barrier(0)
#define AB_DMA(p) do { if (WITH_PV && !(VAR & 1)) __builtin_amdgcn_raw_ptr_buffer_load_lds(drs, (LAS void*)ddst, 16, dvoff, dsoff, (p) * 1024, 0); } while (0)
    f32x16 s0, s1;
#pragma unroll
    for (int r = 0; r < 16; ++r) { s0[r] = 0.f; s1[r] = 0.f; }
#pragma unroll
    for (int ds = 0; ds < 4; ++ds) {
        if (VAR & 4) { asm volatile("" : "+v"(s0), "+v"(s1) : "v"(kf[2 * ds]), "v"(kf[2 * ds + 1])); }
        else { s0 = __builtin_amdgcn_mfma_f32_32x32x16_bf16(kf[2 * ds], qf[ds], s0, 0, 0, 0); s1 = __builtin_amdgcn_mfma_f32_32x32x16_bf16(kf[2 * ds + 1], qf[ds], s1, 0, 0, 0); }
        AB_PIN();
        if (ds == 1) {
#pragma unroll
            for (int d_ = 2; d_ < 4; ++d_) { if (VAR & 16) { asm volatile("" : "=v"(kf[2 * d_])); asm volatile("" : "=v"(kf[2 * d_ + 1])); }
                else { kf[2 * d_] = *(const LAS bf16x8*)(kbc + ((2 * d_ + hi) * 64 + i32) * 16); kf[2 * d_ + 1] = *(const LAS bf16x8*)(kbc + ((2 * d_ + hi) * 64 + 32 + i32) * 16); } }
            AB_DMA(0);
        }
        if (ds == 3) AB_DMA(1);
        AB_PIN();
    }
    if (slow) {
        if (nvalid == 64) {
            const LAS float* lp = lut2 + (relb + 8 * hi - i32 + 185);
#pragma unroll
            for (int r = 0; r < 16; ++r) {
                const int kap = (r & 3) + 4 * ((r >> 2) & 1) + 16 * (r >> 3);
                s0[r] = (s0[r] + lp[kap]) - rho; s1[r] = (s1[r] + lp[kap + 32]) - rho;
            }
        } else {
            const int base = relb + 8 * hi - i32 + 91;
            const float ninf = -INFINITY;
#pragma unroll
            for (int r = 0; r < 16; ++r) {
                const int kap = (r & 3) + 4 * ((r >> 2) & 1) + 16 * (r >> 3);
                const int i0 = min(max(base + kap, 0), NLUT - 1), i1 = min(max(base + kap + 32, 0), NLUT - 1);
                const float m0 = (kap + 8 * hi < nvalid) ? -rho : ninf, m1 = (kap + 8 * hi + 32 < nvalid) ? -rho : ninf;
                s0[r] = (s0[r] + lut[i0]) + m0; s1[r] = (s1[r] + lut[i1]) + m1;
            }
        }
    }
    AB_PIN();
    bf16x8 vf1[4];
    float sum0 = 0.f, sum1 = 0.f, px0 = 0.f, px1 = 0.f;
#define AB_VREAD(dst, base, ks) do { _Pragma("unroll") for (int e_ = 0; e_ < 4; ++e_) { if (VAR & 16) asm volatile("" : "=v"(dst[e_])); \
        else dst[e_] = *(const LAS bf16x8*)((base) + ((2 * (ks) + hi) * 128 + 32 * e_ + i32) * 16); } } while (0)
#define AB_KREAD(d0) do { _Pragma("unroll") for (int d_ = (d0); d_ < (d0) + 2; ++d_) { if (VAR & 16) { asm volatile("" : "=v"(kf[2 * d_])); asm volatile("" : "=v"(kf[2 * d_ + 1])); } \
        else { kf[2 * d_] = *(const LAS bf16x8*)(kbn + ((2 * d_ + hi) * 64 + i32) * 16); kf[2 * d_ + 1] = *(const LAS bf16x8*)(kbn + ((2 * d_ + hi) * 64 + 32 + i32) * 16); } } } while (0)
#pragma unroll
    for (int sk = 0; sk < 4; ++sk) {
#pragma unroll
        for (int eb = 0; eb < 4; ++eb) {
            const int m = 4 * sk + eb;
            if (WITH_PV) { if (VAR & 8) asm volatile("" : "+v"(o[eb]) : "v"((sk & 1) ? vf1[eb] : vf0[eb]), "v"(pwc[sk]));
                           else o[eb] = __builtin_amdgcn_mfma_f32_32x32x16_bf16((sk & 1) ? vf1[eb] : vf0[eb], __builtin_bit_cast(bf16x8, pwc[sk]), o[eb], 0, 0, 0); }
            if (WITH_PV) AB_PIN();
            if (eb == 0) {
                if (WITH_PV && (sk == 0 || sk == 2)) AB_VREAD(vf1, vb, sk + 1);
                if (WITH_PV && sk == 1) AB_VREAD(vf0, vb, 2);
                if (sk == 3) AB_VREAD(vf0, vbn, 0);
            }
            if (sk == 3 && eb == 1) AB_KREAD(0);
            if (WITH_PV) AB_PIN();
            float x0, x1;
            if (VAR & 2) { if (m < 8) { x0 = s0[2 * m]; x1 = s0[2 * m + 1]; } else { x0 = s1[2 * m - 16]; x1 = s1[2 * m - 15]; } }
            else if (m < 8) { x0 = __builtin_amdgcn_exp2f(s0[2 * m]); x1 = __builtin_amdgcn_exp2f(s0[2 * m + 1]); }
            else { x0 = __builtin_amdgcn_exp2f(s1[2 * m - 16]); x1 = __builtin_amdgcn_exp2f(s1[2 * m - 15]); }
            asm volatile("" : "+v"(x0), "+v"(x1));
            AB_PIN();
            if (m > 0) {
                sum0 += px0; sum1 += px1;
                pwn[(m - 1) >> 2][(m - 1) & 3] = cvtpk(px0, px1);
                asm volatile("" : "+v"(pwn[(m - 1) >> 2][(m - 1) & 3]), "+v"(sum0), "+v"(sum1));
            }
            px0 = x0; px1 = x1;
            if (m == 5) AB_DMA(2);
            if (m == 10) AB_DMA(3);
            AB_PIN();
        }
    }
    sum0 += px0; sum1 += px1;
    pwn[3][3] = cvtpk(px0, px1);
#undef AB_VREAD
#undef AB_KREAD
    l += sum0 + sum1;
#undef AB_DMA
#undef AB_PIN
}
constexpr int AT7_KB = 0, AT7_VB = 65536, AT7_LUT = 131072, AT7_CMB = 0;
template <int VAR>
__device__ __forceinline__ void attn_unit7(LAS unsigned char* lds, int bh, int qb, bf16_t* qo, const bf16_t* kimg, const bf16_t* vimg, const bf16_t* kmeta, const bf16_t* vmeta,
                                           const float* lutg, int dry) {
    const int tid = threadIdx.x; int lane = tid & 63; asm volatile("" : "+v"(lane));
    const int i32 = lane & 31, hi = lane >> 5; const int wid = __builtin_amdgcn_readfirstlane(tid >> 6);
    const int b = bh >> 3, h = bh & 7, t = wid >> 2, qblk = wid & 3;
    const int q0 = qb * 128 + qblk * 32;
    const float lam = lutg[NH * NLUT];
    LAS float* lut = (LAS float*)(lds + AT7_LUT); LAS float* lut2 = lut + 192;
    if (tid < NLUT) lut[tid] = lutg[h * NLUT + tid];
    if (tid < NLUT2) lut2[tid] = lutg[LUT2_OFF + h * NLUT2 + tid];
    const unsigned char* ibase = (const unsigned char*)(t ? vimg : kimg);
    const __amdgpu_buffer_rsrc_t drs = __builtin_amdgcn_make_buffer_rsrc((void*)ibase, 0, 0x7fffffff, 0x00020000);
    const int dvoff = lane * 16;
    const int goff = bh * 64 * 16384 + qblk * 4096;
    const int moff = (int)((const unsigned char*)(t ? vmeta : kmeta) - ibase) + h * 16384 + qblk * 4096;
    const unsigned ldst = (unsigned)((t ? AT7_VB : AT7_KB) + qblk * 4096);
#define AT7_DMA(j, slot) do { if (VAR & 1) break; const int so_ = ((j) < 64) ? goff + (j) * 16384 : moff; \
        __builtin_amdgcn_raw_ptr_buffer_load_lds(drs, (LAS void*)(lds + ldst + (slot) * 16384), 16, dvoff, so_, 0, 0); \
        __builtin_amdgcn_raw_ptr_buffer_load_lds(drs, (LAS void*)(lds + ldst + (slot) * 16384), 16, dvoff, so_, 1024, 0); \
        __builtin_amdgcn_raw_ptr_buffer_load_lds(drs, (LAS void*)(lds + ldst + (slot) * 16384), 16, dvoff, so_, 2048, 0); \
        __builtin_amdgcn_raw_ptr_buffer_load_lds(drs, (LAS void*)(lds + ldst + (slot) * 16384), 16, dvoff, so_, 3072, 0); } while (0)
#define AT7_BAR() do { __builtin_amdgcn_sched_barrier(0); __builtin_amdgcn_s_barrier(); __builtin_amdgcn_sched_barrier(0); } while (0)
    AT7_DMA(0, 0); AT7_DMA(1, 1); AT7_DMA(2, 2); if (t == 0) AT7_DMA(3, 3);
    bf16x8 qf[4];
    { const bf16_t* qp = qo + ((size_t)b * SEQ + q0 + i32) * 1024 + h * 128 + t * 64 + hi * 8;
#pragma unroll
      for (int ds = 0; ds < 4; ++ds) qf[ds] = *(const bf16x8*)(qp + ds * 16); }
    f32x16 o[4];
#pragma unroll
    for (int eb = 0; eb < 4; ++eb)
#pragma unroll
        for (int r = 0; r < 16; ++r) o[eb][r] = 0.f;
    float l = 0.f;
    asm volatile("s_waitcnt vmcnt(0) lgkmcnt(0)" ::: "memory");
    AT7_BAR();
    const float cneg = lut[0], cpos = lut[NLUT - 1];
    const int js0 = (q0 + 122 + 63) >> 6, js = (js0 < 64) ? js0 : 1000;
    const float rho_meta = (js0 < 64) ? cpos : cneg;
    const float fsw = __builtin_amdgcn_exp2f(cneg - cpos);
    const float rho = cneg;
    if (t == 1) __builtin_amdgcn_s_setprio(1);
    u32x4 pwc[4], pwn[4];
    bf16x8 kf[8], vf0[4];
    { const LAS unsigned char* kb = lds + AT7_KB + t * 8192;
#pragma unroll
      for (int ds = 0; ds < 4; ++ds) { kf[2 * ds] = *(const LAS bf16x8*)(kb + ((2 * ds + hi) * 64 + i32) * 16); kf[2 * ds + 1] = *(const LAS bf16x8*)(kb + ((2 * ds + hi) * 64 + 32 + i32) * 16); } }
#define AT7_SLOW(j_) (!((j_) < 64 && (64 * (j_) + 63 - q0 <= -91 || 64 * (j_) - (q0 + 31) >= 91)))
    attn_ab7<false, VAR>(kf, vf0, lds + AT7_KB + t * 8192, lds + AT7_KB + 16384 + t * 8192, lds + AT7_VB, lds + AT7_VB, qf, pwn, pwc, o, l, AT7_SLOW(0), rho, -q0, 64, lut, lut2, i32, hi, drs, dvoff, 0, lds);
    AT7_BAR();
#pragma nounroll
    for (int j = 0; j < 64; ++j) {
        const int dj = min(j + (t ? 3 : 4), 64);
        const int dsoff = (dj < 64) ? goff + dj * 16384 : moff;
        LAS unsigned char* ddst = lds + ldst + (dj & 3) * 16384;
        if (j + 1 == js) l *= fsw;
        {
            const int j_ = j + 1;
            attn_ab7<true, VAR>(kf, vf0, lds + AT7_KB + ((j + 1) & 3) * 16384 + t * 8192, lds + AT7_KB + ((j + 2) & 3) * 16384 + t * 8192, lds + AT7_VB + (j & 3) * 16384, lds + AT7_VB + ((j + 1) & 3) * 16384, qf, pwc, pwn, o, l,
                                AT7_SLOW(j_), (j_ < 64) ? cneg : rho_meta, (j_ < 64) ? 64 * j_ - q0 : -NMETA - q0, (j_ < 64) ? 64 : NMETA, lut, lut2, i32, hi, drs, dvoff, dsoff, ddst);
        }
        if (j + 1 == js) {
#pragma unroll
            for (int eb = 0; eb < 4; ++eb)
#pragma unroll
                for (int r = 0; r < 16; ++r) o[eb][r] *= fsw;
        }
        asm volatile("s_waitcnt vmcnt(4)" ::: "memory");
        if (!(VAR & 32)) AT7_BAR();
#pragma unroll
        for (int s_ = 0; s_ < 4; ++s_) pwc[s_] = pwn[s_];
    }
    attn_pv(lds + AT7_VB, pwc, o, i32, hi);
    asm volatile("s_waitcnt vmcnt(0)" ::: "memory");
    AT7_BAR();
    __builtin_amdgcn_s_setprio(0);
#undef AT7_SLOW
#undef AT7_DMA
    const float lt = l + __shfl_xor(l, 32);
    LAS float* cmb = (LAS float*)(lds + AT7_CMB) + qblk * 4096 + lane;
    if (t == 1) { const float sc = lam / lt;
#pragma unroll
        for (int eb = 0; eb < 4; ++eb)
#pragma unroll
            for (int r = 0; r < 16; ++r) cmb[(eb * 16 + r) * 64] = o[eb][r] * sc; }
    asm volatile("s_waitcnt lgkmcnt(0)" ::: "memory");
    AT7_BAR();
    if (t == 0) { const float sc = 1.0f / lt; float ssq = 0.f;
#pragma unroll
        for (int eb = 0; eb < 4; ++eb)
#pragma unroll
            for (int r = 0; r < 16; ++r) { const float v = o[eb][r] * sc - cmb[(eb * 16 + r) * 64]; o[eb][r] = v; ssq += v * v; }
        ssq += __shfl_xor(ssq, 32);
        const float rs = rsqrtf(ssq * (1.0f / 128.0f) + EPS);
        bf16_t* op = qo + ((size_t)b * SEQ + q0 + i32) * 1024 + h * 128 + 4 * hi;
        if (!dry) {
#pragma unroll
        for (int eb = 0; eb < 4; ++eb)
#pragma unroll
            for (int g = 0; g < 4; ++g) { u32x2 w; w.x = cvtpk(o[eb][4 * g] * rs, o[eb][4 * g + 1] * rs); w.y = cvtpk(o[eb][4 * g + 2] * rs, o[eb][4 * g + 3] * rs);
                *(u32x2*)(op + 32 * eb + 8 * g) = w; }
        }
    }
    asm volatile("s_waitcnt lgkmcnt(0)" ::: "memory");
    AT7_BAR();
#undef AT7_BAR
}

__device__ __forceinline__ void attn_bias_blk(f32x16& s, int blk, float rho, int relb, int nvalid, const LAS float* lut, const LAS float* lut2, int i32, int hi) {
    if (nvalid == 64) {
        const LAS float* lp = lut2 + (relb + 8 * hi - i32 + 185 + 32 * blk);
#pragma unroll
        for (int r = 0; r < 16; ++r) { const int kap = (r & 3) + 4 * ((r >> 2) & 1) + 16 * (r >> 3); s[r] = (s[r] + lp[kap]) - rho; }
    } else {
        const int base = relb + 8 * hi - i32 + 91 + 32 * blk;
        const float ninf = -INFINITY;
#pragma unroll
        for (int r = 0; r < 16; ++r) { const int kap = (r & 3) + 4 * ((r >> 2) & 1) + 16 * (r >> 3);
            const int i0 = min(max(base + kap, 0), NLUT - 1);
            const float m0 = (kap + 8 * hi + 32 * blk < nvalid) ? -rho : ninf;
            s[r] = (s[r] + lut[i0]) + m0; }
    }
}
template <bool WITH_PV, int VAR = 0>
__device__ __forceinline__ void attn_ab8(f32x16& s0, bf16x8 (&kfA)[4], bf16x8 (&kfB)[4], bf16x8 (&vf0)[4], const LAS unsigned char* kb2, const LAS unsigned char* vb, const LAS unsigned char* vbn,
                                         const bf16x8 (&qf)[4], const u32x4 (&pwc)[4], u32x4 (&pwn)[4], f32x16 (&o)[4], float& l,
                                         bool slow1, float rho1, int relb1, int nvalid1, bool slow2, float rho2, int relb2, int nvalid2,
                                         const LAS float* lut, const LAS float* lut2, int i32, int hi, __amdgpu_buffer_rsrc_t drs, int dvoff, int dsoff, LAS unsigned char* ddst) {
#define AB_PIN() __builtin_amdgcn_sched_barrier(0)
#define AB_DMA(p) do { if (WITH_PV && !(VAR & 1)) __builtin_amdgcn_raw_ptr_buffer_load_lds(drs, (LAS void*)ddst, 16, dvoff, dsoff, (p) * 1024, 0); } while (0)
#define AB_VREAD(dst, base, ks) do { _Pragma("unroll") for (int e_ = 0; e_ < 4; ++e_) dst[e_] = *(const LAS bf16x8*)((base) + ((2 * (ks) + hi) * 128 + 32 * e_ + i32) * 16); } while (0)
    f32x16 s1, zz;
#pragma unroll
    for (int r = 0; r < 16; ++r) { s1[r] = 0.f; zz[r] = 0.f; }
    bf16x8 vf1[4];
    float sum0 = 0.f, sum1 = 0.f, px0 = 0.f, px1 = 0.f;
#pragma unroll
    for (int m = 0; m < 16; ++m) {
        const int sk = m >> 2, eb = m & 3;
        if (WITH_PV) { o[eb] = __builtin_amdgcn_mfma_f32_32x32x16_bf16((sk & 1) ? vf1[eb] : vf0[eb], __builtin_bit_cast(bf16x8, pwc[sk]), o[eb], 0, 0, 0); AB_PIN(); }
        if (eb == 0) {
            if (WITH_PV && (sk == 0 || sk == 2)) AB_VREAD(vf1, vb, sk + 1);
            if (WITH_PV && sk == 1) AB_VREAD(vf0, vb, 2);
            if (sk == 3) AB_VREAD(vf0, vbn, 0);
        }
        if (m == 1) {
#pragma unroll
            for (int ds = 0; ds < 4; ++ds) kfA[ds] = *(const LAS bf16x8*)(kb2 + ((2 * ds + hi) * 64 + i32) * 16);
        }
        if (m == 9) {
#pragma unroll
            for (int ds = 0; ds < 4; ++ds) kfB[ds] = *(const LAS bf16x8*)(kb2 + ((2 * ds + hi) * 64 + 32 + i32) * 16);
        }
        AB_PIN();
        if (m < 8 && (m & 1) == 0) { const int ds = m >> 1; s1 = __builtin_amdgcn_mfma_f32_32x32x16_bf16(kfB[ds], qf[ds], ds == 0 ? zz : s1, 0, 0, 0); AB_PIN(); }
        if (m >= 8 && (m & 1) == 0) { const int ds = (m - 8) >> 1; s0 = __builtin_amdgcn_mfma_f32_32x32x16_bf16(kfA[ds], qf[ds], ds == 0 ? zz : s0, 0, 0, 0); AB_PIN(); }
        float x0, x1;
        if (m < 8) { x0 = __builtin_amdgcn_exp2f(s0[2 * m]); x1 = __builtin_amdgcn_exp2f(s0[2 * m + 1]); }
        else { x0 = __builtin_amdgcn_exp2f(s1[2 * m - 16]); x1 = __builtin_amdgcn_exp2f(s1[2 * m - 15]); }
        asm volatile("" : "+v"(x0), "+v"(x1));
        AB_PIN();
        if (m > 0) {
            sum0 += px0; sum1 += px1;
            pwn[(m - 1) >> 2][(m - 1) & 3] = cvtpk(px0, px1);
            asm volatile("" : "+v"(pwn[(m - 1) >> 2][(m - 1) & 3]), "+v"(sum0), "+v"(sum1));
        }
        px0 = x0; px1 = x1;
        if (m == 3) AB_DMA(0);
        if (m == 7) AB_DMA(1);
        if (m == 11) AB_DMA(2);
        if (m == 15) AB_DMA(3);
        AB_PIN();
        if (m == 7 && slow1) { attn_bias_blk(s1, 1, rho1, relb1, nvalid1, lut, lut2, i32, hi); }
        if (m == 7) AB_PIN();
    }
    sum0 += px0; sum1 += px1;
    pwn[3][3] = cvtpk(px0, px1);
    if (slow2) attn_bias_blk(s0, 0, rho2, relb2, nvalid2, lut, lut2, i32, hi);
    l += sum0 + sum1;
#undef AB_VREAD
#undef AB_DMA
#undef AB_PIN
}
template <int VAR>
__device__ __forceinline__ void attn_unit8(LAS unsigned char* lds, int bh, int qb, bf16_t* qo, const bf16_t* kimg, const bf16_t* vimg, const bf16_t* kmeta, const bf16_t* vmeta,
                                           const float* lutg, int dry) {
    const int tid = threadIdx.x; int lane = tid & 63; asm volatile("" : "+v"(lane));
    const int i32 = lane & 31, hi = lane >> 5; const int wid = __builtin_amdgcn_readfirstlane(tid >> 6);
    const int b = bh >> 3, h = bh & 7, t = wid >> 2, qblk = wid & 3;
    const int q0 = qb * 128 + qblk * 32;
    const float lam = lutg[NH * NLUT];
    LAS float* lut = (LAS float*)(lds + AT7_LUT); LAS float* lut2 = lut + 192;
    if (tid < NLUT) lut[tid] = lutg[h * NLUT + tid];
    if (tid < NLUT2) lut2[tid] = lutg[LUT2_OFF + h * NLUT2 + tid];
    const unsigned char* ibase = (const unsigned char*)(t ? vimg : kimg);
    const __amdgpu_buffer_rsrc_t drs = __builtin_amdgcn_make_buffer_rsrc((void*)ibase, 0, 0x7fffffff, 0x00020000);
    const int dvoff = lane * 16;
    const int goff = bh * 64 * 16384 + qblk * 4096;
    const int moff = (int)((const unsigned char*)(t ? vmeta : kmeta) - ibase) + h * 16384 + qblk * 4096;
    const unsigned ldst = (unsigned)((t ? AT7_VB : AT7_KB) + qblk * 4096);
#define AT8_DMA(j, slot) do { if (VAR & 1) break; const int so_ = ((j) < 64) ? goff + (j) * 16384 : moff; \
        __builtin_amdgcn_raw_ptr_buffer_load_lds(drs, (LAS void*)(lds + ldst + (slot) * 16384), 16, dvoff, so_, 0, 0); \
        __builtin_amdgcn_raw_ptr_buffer_load_lds(drs, (LAS void*)(lds + ldst + (slot) * 16384), 16, dvoff, so_, 1024, 0); \
        __builtin_amdgcn_raw_ptr_buffer_load_lds(drs, (LAS void*)(lds + ldst + (slot) * 16384), 16, dvoff, so_, 2048, 0); \
        __builtin_amdgcn_raw_ptr_buffer_load_lds(drs, (LAS void*)(lds + ldst + (slot) * 16384), 16, dvoff, so_, 3072, 0); } while (0)
#define AT8_BAR() do { __builtin_amdgcn_sched_barrier(0); __builtin_amdgcn_s_barrier(); __builtin_amdgcn_sched_barrier(0); } while (0)
    AT8_DMA(0, 0); AT8_DMA(1, 1); AT8_DMA(2, 2); if (t == 0) AT8_DMA(3, 3);
    bf16x8 qf[4];
    { const bf16_t* qp = qo + ((size_t)b * SEQ + q0 + i32) * 1024 + h * 128 + t * 64 + hi * 8;
#pragma unroll
      for (int ds = 0; ds < 4; ++ds) qf[ds] = *(const bf16x8*)(qp + ds * 16); }
    f32x16 o[4];
#pragma unroll
    for (int eb = 0; eb < 4; ++eb)
#pragma unroll
        for (int r = 0; r < 16; ++r) o[eb][r] = 0.f;
    float l = 0.f;
    asm volatile("s_waitcnt vmcnt(0) lgkmcnt(0)" ::: "memory");
    AT8_BAR();
    const float cneg = lut[0], cpos = lut[NLUT - 1];
    const int js0 = (q0 + 122 + 63) >> 6, js = (js0 < 64) ? js0 : 1000;
    const float rho_meta = (js0 < 64) ? cpos : cneg;
    const float fsw = __builtin_amdgcn_exp2f(cneg - cpos);
    if (t == 1) __builtin_amdgcn_s_setprio(1);
    u32x4 pwc[4], pwn[4];
    bf16x8 kfA[4], kfB[4], vf0[4];
    f32x16 s0;
#define AT8_SLOW(T) ((T) <= 64 && !((T) < 64 && (64 * (T) + 63 - q0 <= -91 || 64 * (T) - (q0 + 31) >= 91)))
#define AT8_RHO(T) (((T) < 64) ? cneg : rho_meta)
#define AT8_RELB(T) (((T) < 64) ? 64 * (T) - q0 : -NMETA - q0)
#define AT8_NVAL(T) (((T) < 64) ? 64 : NMETA)
    {
        const LAS unsigned char* kb = lds + AT7_KB + t * 8192;
#pragma unroll
        for (int ds = 0; ds < 4; ++ds) { kfA[ds] = *(const LAS bf16x8*)(kb + ((2 * ds + hi) * 64 + i32) * 16); kfB[ds] = *(const LAS bf16x8*)(kb + ((2 * ds + hi) * 64 + 32 + i32) * 16); }
#pragma unroll
        for (int r = 0; r < 16; ++r) s0[r] = 0.f;
#pragma unroll
        for (int ds = 0; ds < 4; ++ds) s0 = __builtin_amdgcn_mfma_f32_32x32x16_bf16(kfA[ds], qf[ds], s0, 0, 0, 0);
        if (AT8_SLOW(0)) attn_bias_blk(s0, 0, AT8_RHO(0), AT8_RELB(0), AT8_NVAL(0), lut, lut2, i32, hi);
    }
    attn_ab8<false, VAR>(s0, kfA, kfB, vf0, lds + AT7_KB + 16384 + t * 8192, lds + AT7_VB, lds + AT7_VB, qf, pwn, pwc, o, l,
                         AT8_SLOW(0), AT8_RHO(0), AT8_RELB(0), AT8_NVAL(0), AT8_SLOW(1), AT8_RHO(1), AT8_RELB(1), AT8_NVAL(1), lut, lut2, i32, hi, drs, dvoff, 0, lds);
    AT8_BAR();
#pragma nounroll
    for (int j = 0; j < 64; ++j) {
        const int dj = min(j + (t ? 3 : 4), 64);
        const int dsoff = (dj < 64) ? goff + dj * 16384 : moff;
        LAS unsigned char* ddst = lds + ldst + (dj & 3) * 16384;
        if (j + 1 == js) l *= fsw;
        {
            const int T1 = j + 1, T2 = j + 2;
            attn_ab8<true, VAR>(s0, kfA, kfB, vf0, lds + AT7_KB + (T2 & 3) * 16384 + t * 8192, lds + AT7_VB + (j & 3) * 16384, lds + AT7_VB + (T1 & 3) * 16384, qf, pwc, pwn, o, l,
                                AT8_SLOW(T1), AT8_RHO(T1), AT8_RELB(T1), AT8_NVAL(T1), AT8_SLOW(T2), AT8_RHO(T2), AT8_RELB(T2), AT8_NVAL(T2), lut, lut2, i32, hi, drs, dvoff, dsoff, ddst);
        }
        if (j + 1 == js) {
#pragma unroll
            for (int eb = 0; eb < 4; ++eb)
#pragma unroll
                for (int r = 0; r < 16; ++r) o[eb][r] *= fsw;
        }
        asm volatile("s_waitcnt vmcnt(4)" ::: "memory");
        AT8_BAR();
#pragma unroll
        for (int s_ = 0; s_ < 4; ++s_) pwc[s_] = pwn[s_];
    }
    attn_pv(lds + AT7_VB, pwc, o, i32, hi);
    asm volatile("s_waitcnt vmcnt(0)" ::: "memory");
    AT8_BAR();
    __builtin_amdgcn_s_setprio(0);
#undef AT8_SLOW
#undef AT8_RHO
#undef AT8_RELB
#undef AT8_NVAL
#undef AT8_DMA
    const float lt = l + __shfl_xor(l, 32);
    LAS float* cmb = (LAS float*)(lds + AT7_CMB) + qblk * 4096 + lane;
    if (t == 1) { const float sc = lam / lt;
#pragma unroll
        for (int eb = 0; eb < 4; ++eb)
#pragma unroll
            for (int r = 0; r < 16; ++r) cmb[(eb * 16 + r) * 64] = o[eb][r] * sc; }
    asm volatile("s_waitcnt lgkmcnt(0)" ::: "memory");
    AT8_BAR();
    if (t == 0) { const float sc = 1.0f / lt; float ssq = 0.f;
#pragma unroll
        for (int eb = 0; eb < 4; ++eb)
#pragma unroll
            for (int r = 0; r < 16; ++r) { const float v = o[eb][r] * sc - cmb[(eb * 16 + r) * 64]; o[eb][r] = v; ssq += v * v; }
        ssq += __shfl_xor(ssq, 32);
        const float rs = rsqrtf(ssq * (1.0f / 128.0f) + EPS);
        bf16_t* op = qo + ((size_t)b * SEQ + q0 + i32) * 1024 + h * 128 + 4 * hi;
        if (!dry) {
#pragma unroll
        for (int eb = 0; eb < 4; ++eb)
#pragma unroll
            for (int g = 0; g < 4; ++g) { u32x2 w; w.x = cvtpk(o[eb][4 * g] * rs, o[eb][4 * g + 1] * rs); w.y = cvtpk(o[eb][4 * g + 2] * rs, o[eb][4 * g + 3] * rs);
                *(u32x2*)(op + 32 * eb + 8 * g) = w; }
        }
    }
    asm volatile("s_waitcnt lgkmcnt(0)" ::: "memory");
    AT8_BAR();
#undef AT8_BAR
}

#define XB_TMO      128
#define XB_XCNT(j)  (256  + 64 * (j))
#define XB_XSUB(j)  (1280 + 64 * (j))
#define XB_XGEN(j)  (2304 + 64 * (j))
#define XB_TOP      3328
#define XB_TOPGEN   3392
#define XCD_BAR_WORDS 3456
#define XB_SPIN_CAP (1u << 20)
__device__ __forceinline__ unsigned xb_ld(unsigned* p)              { return __hip_atomic_load(p, __ATOMIC_RELAXED, __HIP_MEMORY_SCOPE_AGENT); }
__device__ __forceinline__ unsigned xb_add(unsigned* p, unsigned v) { return __hip_atomic_fetch_add(p, v, __ATOMIC_RELAXED, __HIP_MEMORY_SCOPE_AGENT); }
__device__ __forceinline__ unsigned xb_xcc_id() { return (unsigned)__builtin_amdgcn_s_getreg((3 << 11) | 20) & 0xFu; }
#define XB_SPIN(cond, bar) do { unsigned _sp = 0; while (cond) { __builtin_amdgcn_s_sleep(1); \
    if ((++_sp & 255u) == 0u) { if (xb_ld(&(bar)[XB_TMO])) break; if (_sp > XB_SPIN_CAP) { atomicAdd(&(bar)[XB_TMO], 1u); break; } } } } while (0)
struct XcdBarrier { unsigned* bar; unsigned x; volatile LAS unsigned* st; };
__device__ __forceinline__ XcdBarrier xcd_barrier_post(unsigned* bar, volatile LAS unsigned* st) {
    XcdBarrier b; b.bar = bar; b.x = xb_xcc_id(); b.st = st;
    if (threadIdx.x == 0) (void)xb_add(&bar[XB_XCNT(b.x)], 1u);
    return b;
}
__device__ __forceinline__ void xcd_barrier_complete(unsigned* bar, unsigned x, unsigned& nloc, unsigned& nx) {
    const unsigned G = gridDim.x * gridDim.y * gridDim.z;
    unsigned sum, cnt, mine, sp = 0u;
    for (;;) {
        sum = 0u; cnt = 0u; mine = 0u;
#pragma unroll
        for (unsigned j = 0; j < 16; ++j) { const unsigned c = xb_ld(&bar[XB_XCNT(j)]); sum += c; cnt += (c > 0u) ? 1u : 0u; mine = (j == x) ? c : mine; }
        if (sum == G) break;
        __builtin_amdgcn_s_sleep(1);
        if ((++sp & 255u) == 0u) { if (xb_ld(&bar[XB_TMO])) break; if (sp > XB_SPIN_CAP) { atomicAdd(&bar[XB_TMO], 1u); break; } }
    }
    nloc = mine > 0u ? mine : 1u; nx = cnt > 0u ? cnt : 1u;
}
__device__ __forceinline__ void xcd_barrier(const XcdBarrier& b) {
    asm volatile("s_waitcnt vmcnt(0)" ::: "memory");
    __syncthreads();
    if (threadIdx.x == 0) {
        unsigned* bar = b.bar;
        __builtin_amdgcn_s_waitcnt(0);
        unsigned nloc = b.st[0], nx = b.st[1];
        if (nloc == 0u) { xcd_barrier_complete(bar, b.x, nloc, nx); b.st[0] = nloc; b.st[1] = nx; }
        const unsigned old = xb_add(&bar[XB_XSUB(b.x)], 1u);
        const unsigned gen = old / nloc;
        if (old + 1u == (gen + 1u) * nloc) {
            __builtin_amdgcn_fence(__ATOMIC_RELEASE, "agent");
            asm volatile("s_waitcnt vmcnt(0)" ::: "memory");
            const unsigned og = xb_add(&bar[XB_TOP], 1u);
            const unsigned tg = og / nx;
            if (og + 1u == (tg + 1u) * nx) xb_add(&bar[XB_TOPGEN], 1u);
            else XB_SPIN(xb_ld(&bar[XB_TOPGEN]) == tg, bar);
            __builtin_amdgcn_fence(__ATOMIC_ACQUIRE, "agent");
            xb_add(&bar[XB_XGEN(b.x)], 1u);
            asm volatile("s_waitcnt vmcnt(0)" ::: "memory");
        } else {
            XB_SPIN(xb_ld(&bar[XB_XGEN(b.x)]) == gen, bar);
            __builtin_amdgcn_fence(__ATOMIC_ACQUIRE, "agent");
            asm volatile("s_waitcnt vmcnt(0)" ::: "memory");
        }
    }
    __syncthreads();
}

struct Params {
    const float* in[27]; float* out; unsigned char* ws;
};
__device__ __forceinline__ float wave_sum(float v) {
#pragma unroll
    for (int o = 1; o < 64; o <<= 1) v += __shfl_xor(v, o);
    return v;
}
__device__ __forceinline__ void tr_item(const float* W, int ldw, int col0, int k0, bf16_t* WT, int K, int n0, const float* ksc, int kmask, float kmul, LAS float* scr, int lane) {
    float wv[32];
#pragma unroll
    for (int i = 0; i < 32; ++i) wv[i] = W[(size_t)(k0 + 2 * i + (lane >> 5)) * ldw + col0 + (lane & 31)];
#pragma unroll
    for (int i = 0; i < 32; ++i) { const int kk = 2 * i + (lane >> 5); float s = kmul; if (ksc) s *= ksc[(k0 + kk) & kmask];
        scr[kk * 33 + (lane & 31)] = wv[i] * s; }
    asm volatile("s_waitcnt lgkmcnt(0)" ::: "memory");
    const int c = lane & 7;
#pragma unroll
    for (int jj = 0; jj < 4; ++jj) { const int n = (lane >> 3) + 8 * jj; const LAS float* s = scr + (8 * c) * 33 + n;
        u32x4 o; o.x = cvtpk(s[0 * 33], s[1 * 33]); o.y = cvtpk(s[2 * 33], s[3 * 33]); o.z = cvtpk(s[4 * 33], s[5 * 33]); o.w = cvtpk(s[6 * 33], s[7 * 33]);
        *(u32x4*)(WT + (size_t)(n0 + n) * K + k0 + 8 * c) = o; }
    asm volatile("s_waitcnt lgkmcnt(0)" ::: "memory");
}
__device__ __forceinline__ int rel_bucket(int rel) {
    const int n = rel < 0 ? -rel : rel; int bk;
    if (n < 8) bk = n; else { bk = (31 - __builtin_clz((unsigned)(n * n))) + 2; if (bk > 15) bk = 15; }
    return (rel > 0 ? 16 : 0) + bk;
}

__device__ __forceinline__ void s5_prep_part(const Params& P, int g, int part, LAS unsigned char* lds) {
    const float* lam_re = P.in[5]; const float* lam_im = P.in[6]; const float* log_step = P.in[7];
    const float* b_re = P.in[8]; const float* b_im = P.in[9]; const float* c_re = P.in[10]; const float* c_im = P.in[11]; const float* dsk = P.in[12];
    bf16_t* mgt = (bf16_t*)(P.ws + WS_MGT) + (size_t)g * 512 * KY;
    bf16_t* wst = (bf16_t*)(P.ws + WS_WSTT) + (size_t)g * 256 * 512;
    const int tid = threadIdx.x;
    LAS float* apw = (LAS float*)lds;
    LAS float* coef = apw + 2 * 33 * 64 * 2;
    LAS float* kt = coef + 2 * 64 * 2;
    if (tid < 128) {
        const int dr = tid >> 6, p = tid & 63;
        const float dt = expf(log_step[dr * S5G + g]); const float lr = lam_re[(dr * S5G + g) * S5P + p], li = lam_im[(dr * S5G + g) * S5P + p];
        float sn, cs; sincosf(li * dt, &sn, &cs); const float mg = expf(lr * dt); const float ar = mg * cs, ai = mg * sn, den = lr * lr + li * li;
        coef[(dr * 64 + p) * 2] = ((ar - 1.0f) * lr + ai * li) / den; coef[(dr * 64 + p) * 2 + 1] = (ai * lr - (ar - 1.0f) * li) / den;
        float xr = 1.f, xi = 0.f;
        for (int tau = 0; tau <= 32; ++tau) { apw[((dr * 33 + tau) * 64 + p) * 2] = xr; apw[((dr * 33 + tau) * 64 + p) * 2 + 1] = xi;
            const float nr = xr * ar - xi * ai, ni = xr * ai + xi * ar; xr = nr; xi = ni; }
    }
    __syncthreads();
    {
        const int dr = tid >> 8, cl = (tid >> 7) & 1, c = (tid >> 3) & 15, tq = tid & 7, cp = 2 * part + cl;
        float a0 = 0.f, a1 = 0.f, a2 = 0.f, a3 = 0.f;
#pragma unroll 4
        for (int p = 0; p < 64; ++p) {
            const float cr = c_re[((dr * S5G + g) * S5C + cp) * S5P + p], ci = c_im[((dr * S5G + g) * S5C + cp) * S5P + p];
            const float br = b_re[((dr * S5G + g) * S5P + p) * S5C + c], bi = b_im[((dr * S5G + g) * S5P + p) * S5C + c];
            const float kr = coef[(dr * 64 + p) * 2], ki = coef[(dr * 64 + p) * 2 + 1];
            const float btr = kr * br - ki * bi, bti = kr * bi + ki * br;
            const float wr_ = cr * btr - ci * bti, wi_ = cr * bti + ci * btr;
            const LAS float* ap = apw + ((dr * 33 + 4 * tq) * 64 + p) * 2;
            a0 += wr_ * ap[0] - wi_ * ap[1]; a1 += wr_ * ap[128] - wi_ * ap[129]; a2 += wr_ * ap[256] - wi_ * ap[257]; a3 += wr_ * ap[384] - wi_ * ap[385];
        }
        LAS float* kp = kt + ((dr * 32 + 4 * tq) * 2 + cl) * 16 + c;
        kp[0] = a0; kp[32] = a1; kp[64] = a2; kp[96] = a3;
    }
    __syncthreads();
    for (int idx = tid; idx < 64 * 64; idx += 512) {
        const int rl = idx >> 6, kc = idx & 63, tp = rl >> 1, cl = rl & 1, cp = 2 * part + cl, n = tp * 16 + cp, t = kc >> 1, c0 = (kc & 1) * 8, tau = tp - t;
        float v[8];
#pragma unroll
        for (int i = 0; i < 8; ++i) { const int c = c0 + i; float x;
            if (tau > 0) x = kt[((0 * 32 + tau) * 2 + cl) * 16 + c]; else if (tau < 0) x = kt[((1 * 32 - tau) * 2 + cl) * 16 + c];
            else { x = kt[cl * 16 + c] + kt[(32 * 2 + cl) * 16 + c]; if (c == cp) x += dsk[g * 16 + cp]; }
            v[i] = x; }
        u32x4 w; w.x = cvtpk(v[0], v[1]); w.y = cvtpk(v[2], v[3]); w.z = cvtpk(v[4], v[5]); w.w = cvtpk(v[6], v[7]);
        *(u32x4*)(mgt + (size_t)n * KY + kc * 8) = w;
    }
    for (int idx = tid; idx < 64 * 32; idx += 512) {
        const int rl = idx >> 5, pc = idx & 31, tp = rl >> 1, cp = 2 * part + (rl & 1), n = tp * 16 + cp, kq = pc * 8, dr = kq >> 7, reim = (kq >> 6) & 1, p0 = kq & 63;
        const int te = dr ? (32 - tp) : (tp + 1);
        float v[8];
#pragma unroll
        for (int i = 0; i < 8; ++i) { const int p = p0 + i;
            const float cr = c_re[((dr * S5G + g) * S5C + cp) * S5P + p], ci = c_im[((dr * S5G + g) * S5C + cp) * S5P + p];
            const float pr = apw[((dr * 33 + te) * 64 + p) * 2], pim = apw[((dr * 33 + te) * 64 + p) * 2 + 1];
            v[i] = reim ? -(cr * pim + ci * pr) : (cr * pr - ci * pim); }
        u32x4 w; w.x = cvtpk(v[0], v[1]); w.y = cvtpk(v[2], v[3]); w.z = cvtpk(v[4], v[5]); w.w = cvtpk(v[6], v[7]);
        *(u32x4*)(mgt + (size_t)n * KY + 512 + kq) = w;
    }
    for (int idx = tid; idx < 32 * 64; idx += 512) {
        const int rl = idx >> 6, kc = idx & 63, dr = rl >> 4, reim = (rl >> 3) & 1, p = 8 * part + (rl & 7), n = dr * 128 + reim * 64 + p, t = kc >> 1, c0 = (kc & 1) * 8;
        const int te = dr ? t : (31 - t);
        const float pr = apw[((dr * 33 + te) * 64 + p) * 2], pim = apw[((dr * 33 + te) * 64 + p) * 2 + 1];
        const float kr = coef[(dr * 64 + p) * 2], ki = coef[(dr * 64 + p) * 2 + 1];
        float v[8];
#pragma unroll
        for (int i = 0; i < 8; ++i) { const int c = c0 + i;
            const float br = b_re[((dr * S5G + g) * S5P + p) * S5C + c], bi = b_im[((dr * S5G + g) * S5P + p) * S5C + c];
            const float btr = kr * br - ki * bi, bti = kr * bi + ki * br;
            v[i] = reim ? (pr * bti + pim * btr) : (pr * btr - pim * bti); }
        u32x4 w; w.x = cvtpk(v[0], v[1]); w.y = cvtpk(v[2], v[3]); w.z = cvtpk(v[4], v[5]); w.w = cvtpk(v[6], v[7]);
        *(u32x4*)(wst + (size_t)n * 512 + kc * 8) = w;
    }
    __syncthreads();
}

#define PH(k) if constexpr ((MASK >> (k)) & 1)
#define GSYNC() do { if constexpr (MASK == 0x0FFF) xcd_barrier(xbar); } while (0)
#define GSYNC_CG() do { if constexpr (MASK == 0x0FFF) cg::this_grid().sync(); } while (0)
#define PROBE_MASK 0
#define PROBE_VAR 0
#define CLK_SHIFT 0.0f
constexpr int CV_I0 = 16 * 144, CV_I1 = 16 * 32, CV_I2 = 8 * 64, CV_I3 = 16 * 32, CV_I4 = 16 * 32, CV_I5 = 16 * 128, CV_I6 = 64 * 32;
constexpr int CV_B2 = CV_I0 + CV_I1, CV_B5 = CV_B2 + CV_I2 + CV_I3 + CV_I4, CV_END = CV_B5 + CV_I5 + CV_I6;
#define CV_ITEM(it_, scr_) do { int r = (it_); \
    if (r < CV_I0) { const int kb = r / 144, nb = r % 144, n0 = 32 * nb, pn = n0 >> 8, rho = n0 & 255; const int mc = 256 * pn + 64 * ((rho >> 5) & 3) + 32 * (rho >> 7); \
        tr_item(P.in[4], 5632, mc < 2560 ? mc : mc + 1024, 64 * kb, WIN, 1024, n0, P.in[3], 1023, 1.0f, scr_, lane); break; } r -= CV_I0; \
    if (r < CV_I1) { const int kb = r / 32, nb = r % 32; tr_item(P.in[4], 5632, 2560 + 32 * nb, 64 * kb, WIN + (size_t)4608 * 1024, 1024, 32 * nb, P.in[3], 1023, 1.0f, scr_, lane); break; } r -= CV_I1; \
    if (r < CV_I2) { const int kb = r / 64, nb = r % 64, n0 = 32 * nb, pn = n0 >> 8, rho = n0 & 255; \
        tr_item((rho >> 7) ? P.in[14] : P.in[13], 1024, 128 * pn + (rho & 127), 64 * kb, WGLU, 512, n0, nullptr, 0, 1.0f, scr_, lane); break; } r -= CV_I2; \
    if (r < CV_I3) { const int kb = r / 32, nb = r % 32; tr_item(P.in[22], 1024, 32 * nb, 64 * kb, WAO, 1024, 32 * nb, P.in[21], 127, 0.8f, scr_, lane); break; } r -= CV_I3; \
    if (r < CV_I4) { const int kb = r / 32, nb = r % 32; tr_item(P.in[23], 1024, 32 * nb, 64 * kb, WWO, 1024, 32 * nb, nullptr, 0, 1.0f, scr_, lane); break; } r -= CV_I4; \
    if (r < CV_I5) { const int kb = r / 128, nb = r % 128, n0 = 32 * nb, pn = n0 >> 8, rho = n0 & 255; \
        tr_item(P.in[25], 4096, 256 * pn + 64 * ((rho >> 5) & 3) + 32 * (rho >> 7), 64 * kb, WF1, 1024, n0, P.in[24], 1023, 1.0f, scr_, lane); break; } r -= CV_I5; \
    { const int kb = r / 32, nb = r % 32; tr_item(P.in[26], 1024, 32 * nb, 64 * kb, WF2, 4096, 32 * nb, nullptr, 0, 1.0f, scr_, lane); } } while (0)
constexpr int LDS_BYTES = 135168;
template <int MASK, int DRY>
__global__ void __launch_bounds__(512, 2) fwd_megakernel(Params P) {
    extern __shared__ __attribute__((aligned(16))) unsigned char lds_raw[];
    LAS unsigned char* lds = (LAS unsigned char*)lds_raw;
    const int tid = threadIdx.x, lane = tid & 63, wave = __builtin_amdgcn_readfirstlane(tid >> 6);
    const int G = gridDim.x, bx = blockIdx.x;
    const int vcu = (G % 8 == 0) ? (bx % 8) * (G / 8) + bx / 8 : bx;
    unsigned char* ws = P.ws;
    const float* x = P.in[0];
    volatile LAS unsigned* xst = (volatile LAS unsigned*)(lds + LDS_BYTES - 64);
    XcdBarrier xbar; xbar.bar = (unsigned*)(ws + WS_CTL); xbar.x = 0; xbar.st = xst;
    if constexpr (MASK == 0x0FFF || (MASK & 0x1000)) { if (tid < 2) xst[tid] = 0u; __syncthreads(); xbar = xcd_barrier_post((unsigned*)(ws + WS_CTL + (MASK == 0x0FFF ? 0 : 16 * 1024)), xst); }
    const int dry = DRY ? (int)(((const volatile float*)(ws + WS_LUT))[NH * NLUT + 1] != 12345.0f) : 0;
#define XB ((bf16_t*)(ws + WS_XB))
#define RSTD1 ((float*)(ws + WS_RSTD1))
#define WIN ((bf16_t*)(ws + WS_WIN))
#define WGLU ((bf16_t*)(ws + WS_WGLU))
#define WAO ((bf16_t*)(ws + WS_WAO))
#define WWO ((bf16_t*)(ws + WS_WWO))
#define WF1 ((bf16_t*)(ws + WS_WF1))
#define WF2 ((bf16_t*)(ws + WS_WF2))
#define QO ((bf16_t*)(ws + WS_QO))
#define KIMG ((bf16_t*)(ws + WS_KIMG))
#define VIMG ((bf16_t*)(ws + WS_VIMG))
#define KMETA ((bf16_t*)(ws + WS_KMETA))
#define VMETA ((bf16_t*)(ws + WS_VMETA))
#define G1 ((bf16_t*)(ws + WS_G1))
#define G2 ((bf16_t*)(ws + WS_G2))
#define MGT ((bf16_t*)(ws + WS_MGT))
#define UGS ((bf16_t*)(ws + WS_UGS))
#define WSTT ((bf16_t*)(ws + WS_WSTT))
#define SLOC ((float*)(ws + WS_SLOC))
#define GY ((bf16_t*)(ws + WS_GY))
#define H1B ((bf16_t*)(ws + WS_H1B))
#define HBUF ((bf16_t*)(ws + WS_HBUF))
#define SS ((float*)(ws + WS_SS))
#define LUT ((float*)(ws + WS_LUT))
#define UMETA ((float*)(ws + WS_UMETA))

    PH(0) {
        LAS float* scr = (LAS float*)(lds + wave * 8704);
        const int gw = vcu * 8 + wave, NGW = G * 8;
#define P0_TABLES() do {\
        for (int task = bx; task < S5G * 8; task += G) s5_prep_part(P, task >> 3, task & 7, lds);\
        if (bx == G - 1) {\
            const float* tab = P.in[2];\
            for (int idx = tid; idx < NH * NLUT; idx += 512) { const int h = idx / NLUT, rel = idx % NLUT - 91; LUT[idx] = tab[rel_bucket(rel) * NH + h] * LOG2E; }\
            for (int idx = tid; idx < NH * NLUT2; idx += 512) { const int h = idx / NLUT2, rel = idx % NLUT2 - 185; LUT[LUT2_OFF + idx] = tab[rel_bucket(rel) * NH + h] * LOG2E; }\
            if (wave == 0) { const float a = wave_sum(P.in[17][lane] * P.in[18][lane]), c = wave_sum(P.in[19][lane] * P.in[20][lane]);\
                if (lane == 0) LUT[NH * NLUT] = expf(a) - expf(c) + 0.2f; }\
        }\
        for (int it = gw; it < CV_I0 + CV_I1; it += NGW) CV_ITEM(it, scr);\
 } while (0)
#define P0_ROWS() do {\
        for (int r0 = gw * 4; r0 < MPAD; r0 += NGW * 4) {\
            f32x4 v[4][4];\
_Pragma("unroll")\
            for (int q = 0; q < 4; ++q) { const int r = r0 + q;\
                if (r < MTOK + NMETA) { const f32x4* xr = (const f32x4*)((r < MTOK) ? x + (size_t)r * D : P.in[1] + (size_t)(r - MTOK) * D) + lane;\
_Pragma("unroll")\
                    for (int j = 0; j < 4; ++j) v[q][j] = xr[64 * j];\
                } else {\
_Pragma("unroll")\
                    for (int j = 0; j < 4; ++j) v[q][j] = (f32x4){0.f, 0.f, 0.f, 0.f};\
                } }\
_Pragma("unroll")\
            for (int q = 0; q < 4; ++q) { const int r = r0 + q; float sq = 0.f;\
_Pragma("unroll")\
                for (int j = 0; j < 4; ++j) sq += (v[q][j][0] * v[q][j][0] + v[q][j][1] * v[q][j][1]) + (v[q][j][2] * v[q][j][2] + v[q][j][3] * v[q][j][3]);\
                sq = wave_sum(sq);\
                const float rsn = rsqrtf(sq * (1.0f / D) + EPS);\
                u32x2* o8 = (u32x2*)(XB + (size_t)r * D) + lane;\
_Pragma("unroll")\
                for (int j = 0; j < 4; ++j) { u32x2 w; w.x = cvtpk(v[q][j][0] * rsn, v[q][j][1] * rsn); w.y = cvtpk(v[q][j][2] * rsn, v[q][j][3] * rsn); o8[64 * j] = w; } }\
        }\
 } while (0)
        if (bx & 1) { P0_ROWS(); __syncthreads(); P0_TABLES(); } else { P0_TABLES(); __syncthreads(); P0_ROWS(); }
#undef P0_TABLES
#undef P0_ROWS
    }
    GSYNC();

    PH(1) {
        pg8::Gemm g{XB, WIN, 1024, 1024, 1024}; pg8::StaticOrder S; S.init(MTOK / 256, 18, G, bx);
        EpiInMain E{RSTD1, UGS, UMETA, QO, KIMG, KMETA, G1, G2, P.in[15], P.in[16]};
        pg8::gemm_phase<EpiInMain, pg8::StaticOrder, false>(lds, g, S, E);
    }
    PH(11) {
        pg8::Gemm g{XB, WIN + (size_t)4608 * 1024, 1024, 1024, 1024}; pg8::StaticOrder S; S.init(MTOK / 256, 4, G, bx);
        EpiInV E{RSTD1, VIMG, VMETA};
        pg8::gemm_phase<EpiInV, pg8::StaticOrder, true>(lds, g, S, E);
    }
    GSYNC();
    PH(12) { for (int xs = 0; xs < 10; ++xs) xcd_barrier(xbar); }

    PH(2) {
        if (G < 150 || bx < G - 22) {
            pg8::Gemm g{UGS, WSTT, KY, 512, 512}; pg8::GroupOrder<4, 1> S{G < 150 ? G : G - 22, bx};
            EpiSloc E{SLOC};
            pg8::gemm_phase<EpiSloc, pg8::GroupOrder<4, 1>, false>(lds, g, S, E);
        }
        if (G >= 150 && bx >= 128 && bx < G - 22) {
            LAS float* scr2 = (LAS float*)(lds + wave * 8704); const int nw = (G - 22 - 128) * 8, w0 = (bx - 128) * 8 + wave;
            for (int it = CV_B2 + w0; it < CV_B5; it += nw) CV_ITEM(it, scr2);
        } else if (G < 150 && bx == 0) {
            LAS float* scr2 = (LAS float*)(lds + wave * 8704);
            for (int it = CV_B2 + wave; it < CV_B5; it += 8) CV_ITEM(it, scr2);
            __syncthreads();
        }
        if (G < 150 || bx >= G - 4) {
            pg8::Gemm g{XB, WIN + (size_t)4608 * 1024, 1024, 1024, 1024}; pg8::PanelOrder S{MTOK / 256, 4, G < 150 ? G : 4, G < 150 ? bx : bx - (G - 4)};
            EpiInV E{RSTD1, VIMG, VMETA};
            pg8::gemm_phase<EpiInV, pg8::PanelOrder, true>(lds, g, S, E);
        }
        if (G < 150 || (bx >= G - 22 && bx < G - 4)) {
            pg8::Gemm g{XB, WIN, 1024, 1024, 1024}; pg8::PanelOrder S{MTOK / 256, 18, G < 150 ? G : 18, G < 150 ? bx : bx - (G - 22)};
            EpiInMain E{RSTD1, UGS, UMETA, QO, KIMG, KMETA, G1, G2, P.in[15], P.in[16]};
            pg8::gemm_phase<EpiInMain, pg8::PanelOrder, false>(lds, g, S, E);
        }
    }
    GSYNC();

    PH(3) {
        if (G >= 256 && wave >= 2) { LAS float* scr3 = (LAS float*)(lds + wave * 8704); const int nw = G * 6, w0 = bx * 6 + (wave - 2);
            for (int it = CV_B5 + w0; it < CV_END; it += nw) CV_ITEM(it, scr3); }
        else if (G < 256 && bx == 0) { LAS float* scr3 = (LAS float*)(lds + wave * 8704); for (int it = CV_B5 + wave; it < CV_END; it += 8) CV_ITEM(it, scr3); }
        const int gid = (G >= 256) ? ((tid < 128) ? bx * 128 + tid : -1) : (bx * 512 + tid);
        if (gid >= 0 && gid < S5G * BATCH * 2 * S5P) {
            const int p = gid & 63, dr = (gid >> 6) & 1, b = (gid >> 7) & 7, g = gid >> 10;
            const float dt = expf(P.in[7][dr * S5G + g]); const float lr = P.in[5][(dr * S5G + g) * S5P + p], li = P.in[6][(dr * S5G + g) * S5P + p];
            float sn, cs; sincosf(li * dt, &sn, &cs); const float mg = expf(lr * dt); const float a1r = mg * cs, a1i = mg * sn;
            sincosf(li * dt * 32.0f, &sn, &cs); const float mg32 = expf(lr * dt * 32.0f); const float ar = mg32 * cs, ai = mg32 * sn;
            float sr = 0.f, si = 0.f;
            if (dr == 0) {
                const float den = lr * lr + li * li; const float kr = ((a1r - 1.0f) * lr + a1i * li) / den, ki = (a1i * lr - (a1r - 1.0f) * li) / den;
                float btr[16], bti[16];
#pragma unroll
                for (int c = 0; c < 16; ++c) { const float br = P.in[8][((size_t)g * S5P + p) * S5C + c], bi = P.in[9][((size_t)g * S5P + p) * S5C + c]; btr[c] = kr * br - ki * bi; bti[c] = kr * bi + ki * br; }
                for (int m = 0; m < NMETA; ++m) { float xr = 0.f, xi = 0.f;
#pragma unroll
                    for (int c = 0; c < 16; ++c) { const float uv = UMETA[m * S5W + g * 16 + c]; xr += btr[c] * uv; xi += bti[c] * uv; }
                    const float nr = a1r * sr - a1i * si + xr, ni = a1r * si + a1i * sr + xi; sr = nr; si = ni; }
            }
            const size_t rbase = (size_t)g * 1024 + b * 128;
            const float* sl = SLOC + rbase * 256 + dr * 128 + p; bf16_t* so = UGS + rbase * KY + 512 + dr * 128 + p;
            for (int i0 = 0; i0 < NCH; i0 += 32) {
                float lre[32], lim[32];
#pragma unroll
                for (int k = 0; k < 32; ++k) { const int ch = dr ? (NCH - 1 - (i0 + k)) : (i0 + k); lre[k] = sl[(size_t)ch * 256]; lim[k] = sl[(size_t)ch * 256 + 64]; }
#pragma unroll
                for (int k = 0; k < 32; ++k) { const int ch = dr ? (NCH - 1 - (i0 + k)) : (i0 + k);
                    so[(size_t)ch * KY] = (bf16_t)(cvtpk(sr, sr) & 0xffffu); so[(size_t)ch * KY + 64] = (bf16_t)(cvtpk(si, si) & 0xffffu);
                    const float nr = ar * sr - ai * si + lre[k], ni = ar * si + ai * sr + lim[k]; sr = nr; si = ni; }
            }
        }
    }
    GSYNC();

    PH(4) {
        pg8::Gemm g{UGS, MGT, KY, KY, KY}; pg8::GroupOrder<4, 2> S{G, bx};
        EpiY E{GY};
        pg8::gemm_phase<EpiY, pg8::GroupOrder<4, 2>, false>(lds, g, S, E);
    }
    GSYNC();

    PH(5) {
        pg8::Gemm g{GY, WGLU, 512, 512, 512}; pg8::StaticOrder S; S.init(MTOK / 256, 8, G, bx);
        EpiGlu E{G1, dry};
        pg8::gemm_phase<EpiGlu, pg8::StaticOrder, false>(lds, g, S, E);
    }
    unsigned long long ck_t0 = 0, ck_r0 = 0;
    PH(14) { ck_t0 = __builtin_amdgcn_s_memtime(); ck_r0 = __builtin_amdgcn_s_memrealtime(); }
    PH(6) {
        const int nunits = BATCH * NH * (SEQ / 128);
        for (int i = 0; ; ++i) {
            int bh, qb;
            if (G == 256) { if (i >= 8) break; bh = (vcu >> 5) * 8 + i; qb = vcu & 31; }
            else { const int U = i * G + bx; if (U >= nunits) break; bh = U >> 5; qb = U & 31; }
            attn_unit8<DRY ? PROBE_VAR : 0>(lds, bh, qb, QO, KIMG, VIMG, KMETA, VMETA, LUT, dry);
        }
    }
    GSYNC();

    PH(14) {
        const unsigned long long t1 = __builtin_amdgcn_s_memtime(), r1 = __builtin_amdgcn_s_memrealtime();
        const float ghz = (float)(t1 - ck_t0) / (float)(r1 - ck_r0) * 0.1f; const float sc = 1.0f + 0.05f * (floorf((ghz - CLK_SHIFT) / 0.8f) + 1.0f);
        for (size_t i = (size_t)bx * 512 + tid; i < (size_t)MTOK * D / 4; i += (size_t)G * 512) { f32x4 v = ((f32x4*)P.out)[i]; ((f32x4*)P.out)[i] = v * sc; }
    }
    PH(7) {
        pg8::Gemm g{QO, WAO, 1024, 1024, 1024}; pg8::StaticOrder S; S.init(MTOK / 256, 4, G, bx);
        EpiAo E{G1, G2, dry};
        pg8::gemm_phase<EpiAo, pg8::StaticOrder, false>(lds, g, S, E);
    }
    GSYNC();

    PH(8) {
        pg8::Gemm g{G2, WWO, 1024, 1024, 1024}; pg8::StaticOrder S; S.init(MTOK / 256, 4, G, bx);
        EpiWo E{x, P.out, H1B, SS, dry};
        pg8::gemm_phase<EpiWo, pg8::StaticOrder, false>(lds, g, S, E);
    }
    GSYNC();

    PH(9) {
        pg8::Gemm g{H1B, WF1, 1024, 1024, 1024}; pg8::StaticOrder S; S.init(MTOK / 256, 16, G, bx);
        EpiF1 E{SS, HBUF};
        pg8::gemm_phase<EpiF1, pg8::StaticOrder, false>(lds, g, S, E);
    }
    GSYNC();

    PH(10) {
        pg8::Gemm g{HBUF, WF2, 4096, 4096, 4096}; pg8::StaticOrder S; S.init(MTOK / 256, 4, G, bx);
        EpiF2 E{H1B, P.out, dry};
        pg8::gemm_phase<EpiF2, pg8::StaticOrder, false>(lds, g, S, E);
    }
}

extern "C" void kernel_launch(void* const* d_in, const int* in_sizes, int n_in, void* d_out, int out_size, void* d_ws, size_t ws_size, hipStream_t stream) {
    static int grid = 0;
    if (grid == 0) {
        if (n_in != 27 || ws_size < WS_END) { fprintf(stderr, "kernel_launch: unexpected inputs (n_in %d, ws %zu)\n", n_in, ws_size); grid = -1; return; }
        int dev = 0, cus = 0, per_cu = 0;
        (void)hipGetDevice(&dev); (void)hipDeviceGetAttribute(&cus, hipDeviceAttributeMultiprocessorCount, dev);
        (void)hipFuncSetAttribute((const void*)fwd_megakernel<0x0FFF, 0>, hipFuncAttributeMaxDynamicSharedMemorySize, LDS_BYTES);
        if (hipOccupancyMaxActiveBlocksPerMultiprocessor(&per_cu, (const void*)fwd_megakernel<0x0FFF, 0>, 512, LDS_BYTES) != hipSuccess || per_cu < 1) per_cu = 1;
        (void)hipGetLastError();
        grid = cus * 1;
        if (grid <= 0) grid = 256;
    }
    if (grid < 0) return;
    Params p{};
    for (int i = 0; i < 27; ++i) p.in[i] = (const float*)d_in[i];
    p.out = (float*)d_out; p.ws = (unsigned char*)d_ws;
    (void)hipMemsetAsync((char*)d_ws + WS_CTL, 0, CTL_BYTES, stream);
    void* args[] = {&p};
    hipError_t e = hipLaunchCooperativeKernel((const void*)fwd_megakernel<0x0FFF, 0>, dim3(grid), dim3(512), args, LDS_BYTES, stream);
    if (e != hipSuccess) fprintf(stderr, "cooperative launch failed: %s (grid %d)\n", hipGetErrorString(e), grid);
#if PROBE_MASK
    (void)hipFuncSetAttribute((const void*)fwd_megakernel<PROBE_MASK, 1>, hipFuncAttributeMaxDynamicSharedMemorySize, LDS_BYTES);
    if (PROBE_MASK & 0x1000) (void)hipLaunchCooperativeKernel((const void*)fwd_megakernel<PROBE_MASK, 1>, dim3(grid), dim3(512), args, LDS_BYTES, stream);
    else hipLaunchKernelGGL((fwd_megakernel<PROBE_MASK, 1>), dim3(grid), dim3(512), LDS_BYTES, stream, p);
#endif
}
```

```cpp
#include <hip/hip_runtime.h>
#include <hip/hip_cooperative_groups.h>
#include <cstdio>
#include <cstdint>
namespace cg = cooperative_groups;

#define LAS __attribute__((address_space(3)))
typedef unsigned short bf16_t;
typedef short bf16x8 __attribute__((ext_vector_type(8)));
typedef float f32x4 __attribute__((ext_vector_type(4)));
typedef float f32x16 __attribute__((ext_vector_type(16)));
typedef unsigned u32x4 __attribute__((ext_vector_type(4)));
typedef unsigned u32x2 __attribute__((ext_vector_type(2)));
typedef float f32x2_t __attribute__((ext_vector_type(2)));
typedef __bf16 bf16x2_t __attribute__((ext_vector_type(2)));

__device__ __forceinline__ unsigned cvtpk(float lo, float hi) { f32x2_t v = {lo, hi}; bf16x2_t b = __builtin_convertvector(v, bf16x2_t); return __builtin_bit_cast(unsigned, b); }
__device__ __forceinline__ float bf2f(unsigned short h) { return __uint_as_float(((unsigned)h) << 16); }
__device__ __forceinline__ float sigmoidf_(float x) { return __builtin_amdgcn_rcpf(1.0f + __expf(-x)); }

constexpr int D = 1024, BATCH = 8, SEQ = 4096, NMETA = 16;
constexpr int MTOK = BATCH * SEQ;
constexpr int MPAD = MTOK + 256;
constexpr int S5W = 512, S5G = 32, S5C = 16, S5P = 64;
constexpr int NH = 8, HD = 64, VD = 128;
constexpr int DFF = 4096;
constexpr int TCH = 32, NCH = SEQ / TCH;
constexpr int KY = TCH * S5C + 4 * S5P;
constexpr float EPS = 1e-6f;
constexpr float LOG2E = 1.4426950408889634f;
constexpr float QSCALE = 0.125f * LOG2E;
constexpr int NLUT = 183;
constexpr int NLUT2 = 384, LUT2_OFF = 8 * 183 + 8;

constexpr size_t MiB = 1u << 20;
constexpr size_t WS_XB = 0;
constexpr size_t WS_SLOC = 0;
constexpr size_t WS_GY = 32 * MiB;
constexpr size_t WS_QO = 65 * MiB;
constexpr size_t WS_KIMG = 129 * MiB;
constexpr size_t WS_VIMG = 193 * MiB;
constexpr size_t WS_KMETA = 257 * MiB;
constexpr size_t WS_VMETA = 257 * MiB + 128 * 1024;
constexpr size_t WS_HBUF = 0;
constexpr size_t WS_G1 = 258 * MiB;
constexpr size_t WS_G2 = 322 * MiB;
constexpr size_t WS_MGT = 386 * MiB;
constexpr size_t WS_UGS = 410 * MiB;
constexpr size_t WS_WSTT = 458 * MiB;
constexpr size_t WS_H1B = 386 * MiB;
constexpr size_t WS_WIN = 466 * MiB;
constexpr size_t WS_WGLU = 477 * MiB;
constexpr size_t WS_WAO = 479 * MiB;
constexpr size_t WS_WWO = 481 * MiB;
constexpr size_t WS_WF1 = 483 * MiB;
constexpr size_t WS_WF2 = 491 * MiB;
constexpr size_t WS_RSTD1 = 499 * MiB;
constexpr size_t WS_SS = WS_RSTD1 + 256 * 1024;
constexpr size_t WS_LUT = WS_SS + 2 * MiB;
constexpr size_t WS_UMETA = WS_LUT + 32 * 1024;
constexpr size_t WS_CTL = WS_UMETA + 32 * 1024;
constexpr size_t CTL_BYTES = 32 * 1024;
constexpr size_t WS_END = WS_CTL + CTL_BYTES;

namespace pg8 {
constexpr int BM = 256, BK = 64, HALF = 128, HTB = HALF * BK * 2, STAGE_BYTES = 8 * HTB, NXCD = 8, WGM = 8;
__host__ __device__ __forceinline__ int lds_byte(int r, int c) { const int st = (r >> 4) * 2 + (c >> 5), rr = r & 15, cc = c & 31, ob = rr * 64 + cc * 2; return st * 1024 + (ob ^ (((ob >> 9) & 1) << 5)); }
__host__ __device__ __forceinline__ void stage_rc(int b, int& R, int& C) { const int st = b / 1024, sb = b % 1024, swz = sb ^ (((sb >> 9) & 1) << 5); R = (st >> 1) * 16 + swz / 64; C = (st & 1) * 32 + (swz % 64) / 2; }
__host__ __device__ __forceinline__ int perm32(int rho) { const int n = rho >> 4, i = rho & 15; return 8 * (i >> 2) + 4 * n + (i & 3); }

struct Unit { int pm, pn; };
struct Gemm { const bf16_t* A; const bf16_t* Bt; int lda, ldb, K; };

struct StaticOrder {
    int nM, nN, nwg, G, c;
    __device__ void init(int nM_, int nN_, int G_, int c_) { nM = nM_; nN = nN_; nwg = nM * nN; G = G_; c = c_; }
    __device__ bool next(int i, Unit& u) const {
        const long L = (long)i * G + c; if (L >= nwg) return false;
        int wgid = (int)L; { const int q = nwg / NXCD, r = nwg % NXCD, xcd = wgid % NXCD, off = wgid / NXCD; wgid = (xcd < r ? xcd * (q + 1) : r * (q + 1) + (xcd - r) * q) + off; }
        const int nig = WGM * nN, gid = wgid / nig, fm = gid * WGM, gsz = (nM - fm) < WGM ? (nM - fm) : WGM;
        u.pm = fm + ((wgid % nig) % gsz); u.pn = (wgid % nig) / gsz; return true;
    }
};
struct PanelOrder {
    int pm, nN, G, c;
    __device__ bool next(int i, Unit& u) const { const int L = i * G + c; if (L >= nN) return false; u.pm = pm; u.pn = L; return true; }
};
template <int RM, int CN> struct GroupOrder {
    int G, c;
    __device__ bool next(int i, Unit& u) const {
        const int L = i * G + c; if (L >= 32 * RM * CN) return false;
        const int g = L / (RM * CN), r = L % (RM * CN);
        u.pm = g * RM + r / CN; u.pn = g * CN + r % CN; return true;
    }
};

template <class Epi, class Sched, bool SWAP>
__device__ __forceinline__ void gemm_phase(LAS unsigned char* lds, const Gemm g, const Sched& S, const Epi& E) {
    int tid = threadIdx.x; asm volatile("" : "+v"(tid));
    const int wid = __builtin_amdgcn_readfirstlane(tid >> 6), lane = tid & 63, wr = wid >> 2, wc = wid & 3, fr = lane & 15, fq = lane >> 4;
    const int K = g.K, nt = K / BK;
    unsigned voffA[2], voffB[2];
#pragma unroll
    for (int i = 0; i < 2; ++i) { int R, C; stage_rc(tid * 16 + i * 8192, R, C); const int Rb = Epi::PERM ? ((R & ~31) + perm32(R & 31)) : R;
        voffA[i] = (unsigned)(R * g.lda + C) * 2u; voffB[i] = (unsigned)(Rb * g.ldb + C) * 2u; }
    const size_t kstep = (size_t)(BK * 2);
    const size_t hstepA = (size_t)HALF * g.lda * 2, hstepB = (size_t)HALF * g.ldb * 2;
    const size_t tstepA = 2 * hstepA, tstepB = 2 * hstepB;
    const unsigned ldsw = (unsigned)wid * 1024u;
    const int aoff = lds_byte(wr * 64 + fr, fq * 8), boff = lds_byte(wc * 32 + fr, fq * 8);
#define PG8_SA(b, h) (((b) * 2 + (h)) * HTB)
#define PG8_SB(b, h) ((4 + (b) * 2 + (h)) * HTB)
    const __amdgpu_buffer_rsrc_t rsA = __builtin_amdgcn_make_buffer_rsrc((void*)g.A, 0, 0x7fffffff, 0x00020000);
    const __amdgpu_buffer_rsrc_t rsB = __builtin_amdgcn_make_buffer_rsrc((void*)g.Bt, 0, 0x7fffffff, 0x00020000);
#define PG8_STAGE(bufoff, gbase, voff) do { \
        if ((voff) == voffA) { const int so_ = (int)((const char*)(gbase) - (const char*)g.A); \
            __builtin_amdgcn_raw_ptr_buffer_load_lds(rsA, (LAS void*)(lds + (bufoff) + ldsw), 16, (int)voffA[0], so_, 0, 0); \
            __builtin_amdgcn_raw_ptr_buffer_load_lds(rsA, (LAS void*)(lds + (bufoff) + ldsw + 8192), 16, (int)voffA[1], so_, 0, 0); } \
        else { const int so_ = (int)((const char*)(gbase) - (const char*)g.Bt); \
            __builtin_amdgcn_raw_ptr_buffer_load_lds(rsB, (LAS void*)(lds + (bufoff) + ldsw), 16, (int)voffB[0], so_, 0, 0); \
            __builtin_amdgcn_raw_ptr_buffer_load_lds(rsB, (LAS void*)(lds + (bufoff) + ldsw + 8192), 16, (int)voffB[1], so_, 0, 0); } } while (0)
#define PG8_LDA(dst, b, h) do { _Pragma("unroll") for (int m = 0; m < 4; ++m) _Pragma("unroll") for (int k = 0; k < 2; ++k) dst[m][k] = *(const LAS bf16x8*)(lds + PG8_SA(b, h) + aoff + m * 2048 + k * 1024); } while (0)
#define PG8_LDB(dst, b, h) do { _Pragma("unroll") for (int n = 0; n < 2; ++n) _Pragma("unroll") for (int k = 0; k < 2; ++k) dst[n][k] = *(const LAS bf16x8*)(lds + PG8_SB(b, h) + boff + n * 2048 + k * 1024); } while (0)
#define PG8_MMA(ai, bj, At, Bt) do { __builtin_amdgcn_s_setprio(1); _Pragma("unroll") for (int m = 0; m < 4; ++m) _Pragma("unroll") for (int n = 0; n < 2; ++n) _Pragma("unroll") for (int k = 0; k < 2; ++k) \
        acc[ai][bj][m][n] = SWAP ? __builtin_amdgcn_mfma_f32_16x16x32_bf16(At[m][k], Bt[n][k], acc[ai][bj][m][n], 0, 0, 0) \
                                 : __builtin_amdgcn_mfma_f32_16x16x32_bf16(Bt[n][k], At[m][k], acc[ai][bj][m][n], 0, 0, 0); __builtin_amdgcn_s_setprio(0); } while (0)
#define PG8_WAIT_V(n) asm volatile("s_waitcnt vmcnt(" #n ")" ::: "memory")
#define PG8_WAIT_L(n) asm volatile("s_waitcnt lgkmcnt(" #n ")" ::: "memory")
#define PG8_BAR __builtin_amdgcn_s_barrier()
#define PG8_SCHED __builtin_amdgcn_sched_barrier(0)
    Unit cur, nxt; int ui = 0;
    if (!S.next(0, cur)) return;
    f32x4 acc[2][2][4][2];
#pragma unroll
    for (int a = 0; a < 2; ++a)
#pragma unroll
        for (int b = 0; b < 2; ++b)
#pragma unroll
            for (int m = 0; m < 4; ++m)
#pragma unroll
                for (int n = 0; n < 2; ++n) acc[a][b][m][n] = (f32x4){0.f, 0.f, 0.f, 0.f};
    bf16x8 At[4][2], B0[2][2], B1[2][2];
    u32x4 dq[6]; bf16_t* dp = nullptr; int dn = 0;
    const char* cA = (const char*)g.A + (size_t)cur.pm * tstepA; const char* cB = (const char*)g.Bt + (size_t)cur.pn * tstepB;
    PG8_STAGE(PG8_SB(0, 0), cB, voffB); PG8_STAGE(PG8_SB(0, 1), cB + hstepB, voffB); PG8_STAGE(PG8_SA(0, 0), cA, voffA); PG8_STAGE(PG8_SA(0, 1), cA + hstepA, voffA);
    if (wr == 1) PG8_BAR;
    PG8_WAIT_V(2); PG8_BAR;
    PG8_STAGE(PG8_SB(1, 0), cB + kstep, voffB); PG8_STAGE(PG8_SA(1, 0), cA + kstep, voffA); PG8_STAGE(PG8_SB(1, 1), cB + hstepB + kstep, voffB);
    PG8_WAIT_V(6); PG8_BAR;
    for (;;) {
        const bool has_next = S.next(ui + 1, nxt);
        const char* nA = has_next ? (const char*)g.A + (size_t)nxt.pm * tstepA : cA; const char* nB = has_next ? (const char*)g.Bt + (size_t)nxt.pn * tstepB : cB;
        for (int t = 0; t < nt; t += 2) {
            const bool last = (t == nt - 2);
            const char* a1 = cA + (size_t)(t + 1) * kstep;
            const char* a2 = last ? nA : cA + (size_t)(t + 2) * kstep; const char* b2 = last ? nB : cB + (size_t)(t + 2) * kstep;
            const char* a3 = a2 + kstep; const char* b3 = b2 + kstep;
            PG8_LDB(B0, 0, 0); PG8_LDB(B1, 0, 1); PG8_SCHED; PG8_LDA(At, 0, 0); PG8_STAGE(PG8_SA(1, 1), a1 + hstepA, voffA);
            if constexpr (Epi::DEFER) { if (dn > 0) {
                const int qi = t >> 1;
#define PG8_DST(i) if (qi == (i)) *(u32x4*)(dp + (size_t)((i) >> 1) * 16 * Epi::LDC + 32 * ((i) & 1)) = dq[i]
                PG8_DST(0); PG8_DST(1); PG8_DST(2); PG8_DST(3); PG8_DST(4); PG8_DST(5);
                if (qi == 5) dn = 0; } }
            PG8_WAIT_V(8); PG8_WAIT_L(0); PG8_BAR; PG8_MMA(0, 0, At, B0); PG8_MMA(0, 1, At, B1); PG8_BAR; PG8_SCHED;
            PG8_LDA(At, 0, 1); PG8_STAGE(PG8_SB(0, 0), b2, voffB); PG8_STAGE(PG8_SB(0, 1), b2 + hstepB, voffB); PG8_STAGE(PG8_SA(0, 0), a2, voffA);
            PG8_WAIT_V(8); PG8_WAIT_L(0); PG8_BAR; PG8_MMA(1, 0, At, B0); PG8_MMA(1, 1, At, B1); PG8_BAR; PG8_SCHED;
            PG8_LDB(B0, 1, 0); PG8_LDB(B1, 1, 1); PG8_SCHED; PG8_LDA(At, 1, 0); PG8_STAGE(PG8_SA(0, 1), a2 + hstepA, voffA);
            PG8_WAIT_V(8); PG8_WAIT_L(0); PG8_BAR; PG8_MMA(0, 0, At, B0); PG8_MMA(0, 1, At, B1); PG8_BAR; PG8_SCHED;
            PG8_LDA(At, 1, 1); PG8_STAGE(PG8_SB(1, 0), b3, voffB); PG8_STAGE(PG8_SB(1, 1), b3 + hstepB, voffB); PG8_STAGE(PG8_SA(1, 0), a3, voffA);
            PG8_WAIT_V(8); PG8_WAIT_L(0); PG8_BAR; PG8_MMA(1, 0, At, B0); PG8_MMA(1, 1, At, B1); PG8_BAR; PG8_SCHED;
        }
        if (wr == 0) PG8_BAR;
        { int le = lane; asm volatile("" : "+v"(le));
          if constexpr (Epi::DEFER) { E(acc, cur, wr, wc, le & 15, le >> 4, dq, dp); dn = 6;
              if (!has_next || nt < 16) {
#pragma unroll
                  for (int i = 0; i < 6; ++i) *(u32x4*)(dp + (size_t)(i >> 1) * 16 * Epi::LDC + 32 * (i & 1)) = dq[i];
                  dn = 0; } }
          else E(acc, cur, wr, wc, le & 15, le >> 4); }
        if (!has_next) break;
#pragma unroll
        for (int a = 0; a < 2; ++a)
#pragma unroll
            for (int b = 0; b < 2; ++b)
#pragma unroll
                for (int m = 0; m < 4; ++m)
#pragma unroll
                    for (int n = 0; n < 2; ++n) acc[a][b][m][n] = (f32x4){0.f, 0.f, 0.f, 0.f};
        cur = nxt; cA = nA; cB = nB; ++ui;
        if (wr == 1) PG8_BAR;
    }
    PG8_WAIT_V(0);
    PG8_BAR;
#undef PG8_SA
#undef PG8_SB
#undef PG8_STAGE
#undef PG8_LDA
#undef PG8_LDB
#undef PG8_MMA
#undef PG8_WAIT_V
#undef PG8_WAIT_L
#undef PG8_BAR
#undef PG8_SCHED
#undef PG8_DST
}
}
using pg8::Unit;

__device__ __forceinline__ int pi_slot(int k) { return (k & ~12) | ((k & 4) << 1) | ((k & 8) >> 1); }
__device__ __forceinline__ u32x4 pack8(const f32x4 a, const f32x4 b) { u32x4 w; w.x = cvtpk(a[0], a[1]); w.y = cvtpk(a[2], a[3]); w.z = cvtpk(b[0], b[1]); w.w = cvtpk(b[2], b[3]); return w; }

__device__ __forceinline__ float bflo(unsigned w) { return __uint_as_float(w << 16); }
__device__ __forceinline__ float bfhi(unsigned w) { return __uint_as_float(w & 0xffff0000u); }
struct EpiInMain {
    static constexpr bool PERM = true; static constexpr bool DEFER = false;
    const float* rstd1; bf16_t* ugs; float* umeta; bf16_t* qbuf; bf16_t* kimg; bf16_t* kmeta; bf16_t* g1; bf16_t* g2; const float* qn; const float* kn;
    __device__ __forceinline__ void operator()(const f32x4 (&acc)[2][2][4][2], const Unit& u, int wr, int wc, int fr, int fq) const {
        const int pn = u.pn, pm = u.pm; const bool meta = (pm == MTOK / 256);
        const int b = pm >> 4;
        f32x4 gw[2][2];
        { const float* gp = (pn < 6) ? qn : kn; const float sc = (pn < 6) ? QSCALE : 1.0f;
#pragma unroll
          for (int bj = 0; bj < 2; ++bj)
#pragma unroll
              for (int n = 0; n < 2; ++n) gw[bj][n] = (pn >= 2 && pn < 10) ? *(const f32x4*)(gp + 32 * bj + 8 * fq + 4 * n) * sc : (f32x4){1.f, 1.f, 1.f, 1.f}; }
#pragma unroll
        for (int ai = 0; ai < 2; ++ai)
#pragma unroll
            for (int m = 0; m < 4; ++m) {
                const int rloc = ai * 128 + wr * 64 + m * 16 + fr;
                const int r = pm * 256 + rloc;
                const int j = (pm & 15) * 256 + rloc;
                f32x4 v[2][2];
#pragma unroll
                for (int bj = 0; bj < 2; ++bj)
#pragma unroll
                    for (int n = 0; n < 2; ++n) v[bj][n] = acc[ai][bj][m][n];
                if (pn < 2) {
#pragma unroll
                    for (int bj = 0; bj < 2; ++bj) {
                        const int c = 256 * pn + 64 * wc + 32 * bj + 8 * fq;
                        if (!meta) { const int gg = c >> 4, c0 = c & 15;
                            bf16_t* dst = ugs + ((size_t)gg * (BATCH * NCH) + b * NCH + (j >> 5)) * KY + (j & 31) * 16 + c0;
                            *(u32x4*)dst = pack8(v[bj][0], v[bj][1]);
                        } else if (rloc < NMETA) { float* dst = umeta + rloc * S5W + c; *(f32x4*)dst = v[bj][0]; *(f32x4*)(dst + 4) = v[bj][1]; }
                    }
                } else if (pn < 10) {
                    float ss = 0.f;
#pragma unroll
                    for (int bj = 0; bj < 2; ++bj)
#pragma unroll
                        for (int n = 0; n < 2; ++n) { const f32x4 x = v[bj][n]; ss += (x[0] * x[0] + x[1] * x[1]) + (x[2] * x[2] + x[3] * x[3]); }
                    ss += __shfl_xor(ss, 16); ss += __shfl_xor(ss, 32);
                    const float sc = rsqrtf(ss * (1.0f / 64.0f) + EPS);
#pragma unroll
                    for (int bj = 0; bj < 2; ++bj) {
                        const f32x4 o0 = v[bj][0] * gw[bj][0] * sc, o1 = v[bj][1] * gw[bj][1] * sc;
                        const u32x4 w = pack8(o0, o1);
                        if (pn < 6) { if (!meta) { const int cq = 256 * (pn - 2) + 64 * wc + 32 * bj + 8 * fq; *(u32x4*)(qbuf + (size_t)r * 1024 + cq) = w; } }
                        else { const int h = 2 * (pn - 6) + (wc >> 1), chunk = 8 * (wc & 1) + 4 * bj + fq;
                            if (!meta) { const int tile = j >> 6, slot = pi_slot(j & 63);
                                *(u32x4*)(kimg + ((((size_t)(b * NH + h) * 64 + tile) * 16 + chunk) * 64 + slot) * 8) = w;
                            } else if (rloc < 64) { *(u32x4*)(kmeta + (((size_t)h * 16 + chunk) * 64 + pi_slot(rloc)) * 8) = w; } }
                    }
                } else {
                    if (!meta) { bf16_t* gb = (pn < 14) ? g1 : g2; const int pg = (pn < 14) ? pn - 10 : pn - 14;
#pragma unroll
                        for (int bj = 0; bj < 2; ++bj) { f32x4 o0, o1;
#pragma unroll
                            for (int i = 0; i < 4; ++i) { o0[i] = sigmoidf_(v[bj][0][i]); o1[i] = sigmoidf_(v[bj][1][i]); }
                            *(u32x4*)(gb + (size_t)r * 1024 + 256 * pg + 64 * wc + 32 * bj + 8 * fq) = pack8(o0, o1); } }
                }
            }
    }
};
struct EpiInV {
    static constexpr bool PERM = false; static constexpr bool DEFER = false;
    const float* rstd1; bf16_t* vimg; bf16_t* vmeta;
    __device__ __forceinline__ void operator()(const f32x4 (&acc)[2][2][4][2], const Unit& u, int wr, int wc, int fr, int fq) const {
        const int pn = u.pn, pm = u.pm; const bool meta = (pm == MTOK / 256); const int b = pm >> 4;
#pragma unroll
        for (int ai = 0; ai < 2; ++ai) {
            if (meta && (ai | wr)) continue;
            const int tile = (pm & 15) * 4 + 2 * ai + wr;
#pragma unroll
            for (int m = 0; m < 4; ++m) {
                const int kvchunk = 2 * m + (fq >> 1), within = 4 * (fq & 1);
#pragma unroll
                for (int bj = 0; bj < 2; ++bj)
#pragma unroll
                    for (int n = 0; n < 2; ++n) {
                        const int h = 2 * pn + bj, e = 32 * wc + 16 * n + fr;
                        const f32x4 x = acc[ai][bj][m][n];
                        u32x2 w; w.x = cvtpk(x[0], x[1]); w.y = cvtpk(x[2], x[3]);
                        bf16_t* dst = meta ? vmeta + (((size_t)h * 8 + kvchunk) * 128 + e) * 8 + within
                                           : vimg + ((((size_t)(b * NH + h) * 64 + tile) * 8 + kvchunk) * 128 + e) * 8 + within;
                        *(u32x2*)dst = w;
                    }
            }
        }
    }
};
struct EpiSloc {
    static constexpr bool PERM = true; static constexpr bool DEFER = false;
    float* sloc;
    __device__ __forceinline__ void operator()(const f32x4 (&acc)[2][2][4][2], const Unit& u, int wr, int wc, int fr, int fq) const {
#pragma unroll
        for (int ai = 0; ai < 2; ++ai)
#pragma unroll
            for (int m = 0; m < 4; ++m) { const int r = u.pm * 256 + ai * 128 + wr * 64 + m * 16 + fr;
#pragma unroll
                for (int bj = 0; bj < 2; ++bj) { float* dst = sloc + (size_t)r * 256 + 128 * bj + 32 * wc + 8 * fq;
                    *(f32x4*)dst = acc[ai][bj][m][0]; *(f32x4*)(dst + 4) = acc[ai][bj][m][1]; } }
    }
};
__device__ __forceinline__ float gelu_tanh(float x) { const float u = 0.7978845608028654f * (x + 0.044715f * x * x * x); return x * __builtin_amdgcn_rcpf(1.0f + __expf(-2.0f * u)); }
struct EpiY {
    static constexpr bool PERM = true; static constexpr bool DEFER = false;
    bf16_t* gy;
    __device__ __forceinline__ void operator()(const f32x4 (&acc)[2][2][4][2], const Unit& u, int wr, int wc, int fr, int fq) const {
        const int g = u.pm >> 2;
#pragma unroll
        for (int ai = 0; ai < 2; ++ai)
#pragma unroll
            for (int m = 0; m < 4; ++m) { const int rg = (u.pm & 3) * 256 + ai * 128 + wr * 64 + m * 16 + fr;
                const int b = rg >> 7, ch = rg & 127;
#pragma unroll
                for (int bj = 0; bj < 2; ++bj) { const int n0 = 256 * (u.pn & 1) + 128 * bj + 32 * wc + 8 * fq; const int tp = n0 >> 4, c0 = n0 & 15;
                    f32x4 o0, o1;
#pragma unroll
                    for (int i = 0; i < 4; ++i) { o0[i] = gelu_tanh(acc[ai][bj][m][0][i]); o1[i] = gelu_tanh(acc[ai][bj][m][1][i]); }
                    *(u32x4*)(gy + ((size_t)b * SEQ + ch * TCH + tp) * S5W + g * 16 + c0) = pack8(o0, o1); } }
    }
};
struct EpiGlu {
    static constexpr bool PERM = true; static constexpr bool DEFER = false;
    bf16_t* g1; int dry;
    __device__ __forceinline__ void operator()(const f32x4 (&acc)[2][2][4][2], const Unit& u, int wr, int wc, int fr, int fq) const {
        u32x4 gv[2][4];
#pragma unroll
        for (int ai = 0; ai < 2; ++ai)
#pragma unroll
            for (int m = 0; m < 4; ++m) gv[ai][m] = *(const u32x4*)(g1 + (size_t)(u.pm * 256 + ai * 128 + wr * 64 + m * 16 + fr) * 1024 + 128 * u.pn + 32 * wc + 8 * fq);
#pragma unroll
        for (int ai = 0; ai < 2; ++ai)
#pragma unroll
            for (int m = 0; m < 4; ++m) { const int r = u.pm * 256 + ai * 128 + wr * 64 + m * 16 + fr;
                bf16_t* p = g1 + (size_t)r * 1024 + 128 * u.pn + 32 * wc + 8 * fq;
                const u32x4 g = gv[ai][m]; f32x4 o0, o1;
#pragma unroll
                for (int i = 0; i < 4; ++i) {
                    const float ga = (i & 1) ? bfhi(g[i >> 1]) : bflo(g[i >> 1]), gb = (i & 1) ? bfhi(g[2 + (i >> 1)]) : bflo(g[2 + (i >> 1)]);
                    o0[i] = acc[ai][0][m][0][i] * sigmoidf_(acc[ai][1][m][0][i]) * ga;
                    o1[i] = acc[ai][0][m][1][i] * sigmoidf_(acc[ai][1][m][1][i]) * gb; }
                if (!dry) *(u32x4*)p = pack8(o0, o1); }
    }
};
struct EpiAo {
    static constexpr bool PERM = true; static constexpr bool DEFER = false;
    const bf16_t* t2; bf16_t* g2; int dry;
    __device__ __forceinline__ void operator()(const f32x4 (&acc)[2][2][4][2], const Unit& u, int wr, int wc, int fr, int fq) const {
        u32x4 gv[2][2][2], tv[2][2][2];
#define AO_OFF(q, mm, bj) ((size_t)(u.pm * 256 + ((q) >> 1) * 128 + wr * 64 + (((q) & 1) * 2 + (mm)) * 16 + fr) * 1024 + 256 * u.pn + 128 * (bj) + 32 * wc + 8 * fq)
#define AO_LOAD(buf, q) do { _Pragma("unroll") for (int mm = 0; mm < 2; ++mm) _Pragma("unroll") for (int bj = 0; bj < 2; ++bj) { \
            gv[buf][mm][bj] = *(const u32x4*)(g2 + AO_OFF(q, mm, bj)); tv[buf][mm][bj] = *(const u32x4*)(t2 + AO_OFF(q, mm, bj)); } } while (0)
        AO_LOAD(0, 0);
#pragma unroll
        for (int q = 0; q < 4; ++q) {
            if (q + 1 < 4) { if (q & 1) AO_LOAD(0, q + 1); else AO_LOAD(1, q + 1); }
#pragma unroll
            for (int mm = 0; mm < 2; ++mm)
#pragma unroll
                for (int bj = 0; bj < 2; ++bj) { const u32x4 g = gv[q & 1][mm][bj], t = tv[q & 1][mm][bj]; const int ai = q >> 1, m = (q & 1) * 2 + mm; f32x4 o0, o1;
#pragma unroll
                    for (int i = 0; i < 4; ++i) {
                        const float ga = (i & 1) ? bfhi(g[i >> 1]) : bflo(g[i >> 1]), gb = (i & 1) ? bfhi(g[2 + (i >> 1)]) : bflo(g[2 + (i >> 1)]);
                        const float ta = (i & 1) ? bfhi(t[i >> 1]) : bflo(t[i >> 1]), tb = (i & 1) ? bfhi(t[2 + (i >> 1)]) : bflo(t[2 + (i >> 1)]);
                        o0[i] = ta + ga * acc[ai][bj][m][0][i]; o1[i] = tb + gb * acc[ai][bj][m][1][i]; }
                    if (!dry) *(u32x4*)(g2 + AO_OFF(q, mm, bj)) = pack8(o0, o1); }
        }
#undef AO_LOAD
#undef AO_OFF
    }
};
struct EpiWo {
    static constexpr bool PERM = false; static constexpr bool DEFER = false;
    const float* x; float* out; bf16_t* h1b; float* ss; int dry;
    __device__ __forceinline__ void operator()(const f32x4 (&acc)[2][2][4][2], const Unit& u, int wr, int wc, int fr, int fq) const {
        f32x4 xv[2][2][2][2];
#define WO_OFF(q, mm, bj, n) ((size_t)(u.pm * 256 + ((q) >> 1) * 128 + wr * 64 + (((q) & 1) * 2 + (mm)) * 16 + fr) * 1024 + 256 * u.pn + 128 * (bj) + 32 * wc + 16 * (n) + 4 * fq)
#define WO_LOAD(buf, q) do { _Pragma("unroll") for (int mm = 0; mm < 2; ++mm) _Pragma("unroll") for (int bj = 0; bj < 2; ++bj) _Pragma("unroll") for (int n = 0; n < 2; ++n) \
            xv[buf][mm][bj][n] = *(const f32x4*)(x + WO_OFF(q, mm, bj, n)); } while (0)
        WO_LOAD(0, 0);
#pragma unroll
        for (int q = 0; q < 4; ++q) {
            if (q + 1 < 4) { if (q & 1) WO_LOAD(0, q + 1); else WO_LOAD(1, q + 1); }
#pragma unroll
            for (int mm = 0; mm < 2; ++mm) { const int ai = q >> 1, m = (q & 1) * 2 + mm; const int r = u.pm * 256 + ai * 128 + wr * 64 + m * 16 + fr; float sq = 0.f;
#pragma unroll
                for (int bj = 0; bj < 2; ++bj)
#pragma unroll
                    for (int n = 0; n < 2; ++n) { const size_t off = WO_OFF(q, mm, bj, n);
                        const f32x4 h = xv[q & 1][mm][bj][n] + acc[ai][bj][m][n];
                        u32x2 w; w.x = cvtpk(h[0], h[1]); w.y = cvtpk(h[2], h[3]); if (!dry) *(u32x2*)(h1b + off) = w;
                        sq += (h[0] * h[0] + h[1] * h[1]) + (h[2] * h[2] + h[3] * h[3]); }
                sq += __shfl_xor(sq, 16); sq += __shfl_xor(sq, 32);
                if (fq == 0) ss[(size_t)r * 16 + u.pn * 4 + wc] = sq; }
        }
#undef WO_LOAD
#undef WO_OFF
    }
};
struct EpiF1 {
    static constexpr bool PERM = true; static constexpr bool DEFER = true; static constexpr int LDC = DFF;
    const float* ss; bf16_t* hb;
    __device__ __forceinline__ void operator()(const f32x4 (&acc)[2][2][4][2], const Unit& u, int wr, int wc, int fr, int fq, u32x4 (&dq)[6], bf16_t*& dp) const {
        float rsv[2][4];
        {
            f32x4 sv[2][4];
#pragma unroll
            for (int ai = 0; ai < 2; ++ai)
#pragma unroll
                for (int m = 0; m < 4; ++m) sv[ai][m] = *(const f32x4*)(ss + (size_t)(u.pm * 256 + ai * 128 + wr * 64 + m * 16 + fr) * 16 + 4 * fq);
#pragma unroll
            for (int ai = 0; ai < 2; ++ai)
#pragma unroll
                for (int m = 0; m < 4; ++m) { float tot = (sv[ai][m][0] + sv[ai][m][1]) + (sv[ai][m][2] + sv[ai][m][3]);
                    tot += __shfl_xor(tot, 16); tot += __shfl_xor(tot, 32);
                    rsv[ai][m] = rsqrtf(tot * (1.0f / 1024.0f) + EPS); }
        }
        dp = hb + (size_t)(u.pm * 256 + wr * 64 + fr) * DFF + 256 * u.pn + 64 * wc + 8 * fq;
#pragma unroll
        for (int ai = 1; ai >= 0; --ai)
#pragma unroll
            for (int m = 0; m < 4; ++m) { const int r = u.pm * 256 + ai * 128 + wr * 64 + m * 16 + fr; const float rs = rsv[ai][m];
#pragma unroll
                for (int bj = 0; bj < 2; ++bj) { f32x4 o0, o1;
#pragma unroll
                    for (int i = 0; i < 4; ++i) { const float a0 = fmaxf(acc[ai][bj][m][0][i] * rs, 0.f), a1 = fmaxf(acc[ai][bj][m][1][i] * rs, 0.f); o0[i] = a0 * a0; o1[i] = a1 * a1; }
                    if (ai == 1 || m >= 3) *(u32x4*)(hb + (size_t)r * DFF + 256 * u.pn + 64 * wc + 32 * bj + 8 * fq) = pack8(o0, o1);
                    else dq[2 * m + bj] = pack8(o0, o1); } }
    }
};
struct EpiF2 {
    static constexpr bool PERM = false; static constexpr bool DEFER = false;
    const bf16_t* h1b; float* out; int dry;
    __device__ __forceinline__ void operator()(const f32x4 (&acc)[2][2][4][2], const Unit& u, int wr, int wc, int fr, int fq) const {
        u32x2 xv[2][2][2][2];
#define F2_OFF(q, mm, bj, n) ((size_t)(u.pm * 256 + ((q) >> 1) * 128 + wr * 64 + (((q) & 1) * 2 + (mm)) * 16 + fr) * 1024 + 256 * u.pn + 128 * (bj) + 32 * wc + 16 * (n) + 4 * fq)
#define F2_LOAD(buf, q) do { _Pragma("unroll") for (int mm = 0; mm < 2; ++mm) _Pragma("unroll") for (int bj = 0; bj < 2; ++bj) _Pragma("unroll") for (int n = 0; n < 2; ++n) \
            xv[buf][mm][bj][n] = *(const u32x2*)(h1b + F2_OFF(q, mm, bj, n)); } while (0)
        F2_LOAD(0, 0);
#pragma unroll
        for (int q = 0; q < 4; ++q) {
            if (q + 1 < 4) { if (q & 1) F2_LOAD(0, q + 1); else F2_LOAD(1, q + 1); }
#pragma unroll
            for (int mm = 0; mm < 2; ++mm) { const int ai = q >> 1, m = (q & 1) * 2 + mm;
#pragma unroll
                for (int bj = 0; bj < 2; ++bj)
#pragma unroll
                    for (int n = 0; n < 2; ++n) { const u32x2 w = xv[q & 1][mm][bj][n]; const f32x4 h = {bflo(w.x), bfhi(w.x), bflo(w.y), bfhi(w.y)};
                        const f32x4 v = h + acc[ai][bj][m][n]; if (!dry) *(f32x4*)(out + F2_OFF(q, mm, bj, n)) = v; } }
        }
#undef F2_LOAD
#undef F2_OFF
    }
};

__device__ __forceinline__ int crow(int r, int hi) { return (r & 3) + 8 * (r >> 2) + 4 * hi; }
__device__ __forceinline__ void attn_pv(const LAS unsigned char* vb, const u32x4 (&pw)[4], f32x16 (&o)[4], int i32, int hi) {
    bf16x8 vf[2][4];
#pragma unroll
    for (int s_ = 0; s_ < 4; ++s_) {
#pragma unroll
        for (int eb = 0; eb < 4; ++eb) vf[s_ & 1][eb] = *(const LAS bf16x8*)(vb + ((2 * s_ + hi) * 128 + 32 * eb + i32) * 16);
#pragma unroll
        for (int eb = 0; eb < 4; ++eb) o[eb] = __builtin_amdgcn_mfma_f32_32x32x16_bf16(vf[s_ & 1][eb], __builtin_bit_cast(bf16x8, pw[s_]), o[eb], 0, 0, 0);
    }
}

struct AbMid { f32x16 s1; float sum0, sum1, px0, px1; bf16x8 vf1[4]; };
constexpr int AB_SPLIT = 12;
template <bool WITH_PV, int PART>
__device__ __forceinline__ void attn_ab10(AbMid& md, bf16x8 (&kf)[8], bf16x8 (&vf0)[4], const LAS unsigned char* kbc, const LAS unsigned char* kbn, const LAS unsigned char* vb, const LAS unsigned char* vbn,
                                          const bf16x8 (&qf)[4], const u32x4 (&pwc)[4], u32x4 (&pwn)[4], f32x16 (&o)[4], float& l,
                                          bool slow, float rho, int relb, int nvalid, const LAS float* lut, const LAS float* lut2, int i32, int hi,
                                          __amdgpu_buffer_rsrc_t drs, int dvoff, int dsoff, LAS unsigned char* ddst) {
#define AB_PIN() __builtin_amdgcn_sched_barrier(0)
#define AB_DMA(p) do { if (WITH_PV) __builtin_amdgcn_raw_ptr_buffer_load_lds(drs, (LAS void*)ddst, 16, dvoff, dsoff, (p) * 1024, 0); } while (0)
    f32x16 s0, s1;
    float sum0, sum1, px0, px1;
    if (PART != 2) {
#pragma unroll
        for (int r = 0; r < 16; ++r) { s0[r] = 0.f; s1[r] = 0.f; }
#pragma unroll
        for (int ds = 0; ds < 4; ++ds) {
            s0 = __builtin_amdgcn_mfma_f32_32x32x16_bf16(kf[2 * ds], qf[ds], s0, 0, 0, 0); s1 = __builtin_amdgcn_mfma_f32_32x32x16_bf16(kf[2 * ds + 1], qf[ds], s1, 0, 0, 0);
            AB_PIN();
            if (ds == 1) {
#pragma unroll
                for (int d_ = 2; d_ < 4; ++d_) { kf[2 * d_] = *(const LAS bf16x8*)(kbc + ((2 * d_ + hi) * 64 + i32) * 16); kf[2 * d_ + 1] = *(const LAS bf16x8*)(kbc + ((2 * d_ + hi) * 64 + 32 + i32) * 16); }
                AB_DMA(0);
            }
            if (ds == 3) AB_DMA(1);
            AB_PIN();
        }
        if (slow) {
            if (nvalid == 64) {
                const LAS float* lp = lut2 + (relb + 8 * hi - i32 + 185);
#pragma unroll
                for (int r = 0; r < 16; ++r) { const int kap = (r & 3) + 4 * ((r >> 2) & 1) + 16 * (r >> 3);
                    s0[r] = (s0[r] + lp[kap]) - rho; s1[r] = (s1[r] + lp[kap + 32]) - rho; }
            } else {
                const int base = relb + 8 * hi - i32 + 91;
                const float ninf = -INFINITY;
#pragma unroll
                for (int r = 0; r < 16; ++r) { const int kap = (r & 3) + 4 * ((r >> 2) & 1) + 16 * (r >> 3);
                    const int i0 = min(max(base + kap, 0), NLUT - 1), i1 = min(max(base + kap + 32, 0), NLUT - 1);
                    const float m0 = (kap + 8 * hi < nvalid) ? -rho : ninf, m1 = (kap + 8 * hi + 32 < nvalid) ? -rho : ninf;
                    s0[r] = (s0[r] + lut[i0]) + m0; s1[r] = (s1[r] + lut[i1]) + m1; }
            }
        }
        AB_PIN();
        sum0 = 0.f; sum1 = 0.f; px0 = 0.f; px1 = 0.f;
    }
    bf16x8 vf1[4];
    if (PART == 2) { s1 = md.s1; sum0 = md.sum0; sum1 = md.sum1; px0 = md.px0; px1 = md.px1;
#pragma unroll
        for (int e_ = 0; e_ < 4; ++e_) vf1[e_] = md.vf1[e_]; }
#define AB_VREAD(dst, base, ks) do { _Pragma("unroll") for (int e_ = 0; e_ < 4; ++e_) dst[e_] = *(const LAS bf16x8*)((base) + ((2 * (ks) + hi) * 128 + 32 * e_ + i32) * 16); } while (0)
#define AB_KREAD(d0) do { _Pragma("unroll") for (int d_ = (d0); d_ < (d0) + 2; ++d_) { kf[2 * d_] = *(const LAS bf16x8*)(kbn + ((2 * d_ + hi) * 64 + i32) * 16); kf[2 * d_ + 1] = *(const LAS bf16x8*)(kbn + ((2 * d_ + hi) * 64 + 32 + i32) * 16); } } while (0)
#pragma unroll
    for (int sk = 0; sk < 4; ++sk) {
#pragma unroll
        for (int eb = 0; eb < 4; ++eb) {
            const int m = 4 * sk + eb;
            if ((PART == 1 && m >= AB_SPLIT) || (PART == 2 && m < AB_SPLIT)) continue;
            if (WITH_PV) { o[eb] = __builtin_amdgcn_mfma_f32_32x32x16_bf16((sk & 1) ? vf1[eb] : vf0[eb], __builtin_bit_cast(bf16x8, pwc[sk]), o[eb], 0, 0, 0); AB_PIN(); }
            if (eb == 0) {
                if (WITH_PV && (sk == 0 || sk == 2)) AB_VREAD(vf1, vb, sk + 1);
                if (WITH_PV && sk == 1) AB_VREAD(vf0, vb, 2);
                if (sk == 3) AB_VREAD(vf0, vbn, 0);
            }
            if (sk == 3 && eb == 1) AB_KREAD(0);
            if (WITH_PV) AB_PIN();
            float x0, x1;
            if (m < 8) { x0 = __builtin_amdgcn_exp2f(s0[2 * m]); x1 = __builtin_amdgcn_exp2f(s0[2 * m + 1]); }
            else { x0 = __builtin_amdgcn_exp2f(s1[2 * m - 16]); x1 = __builtin_amdgcn_exp2f(s1[2 * m - 15]); }
            asm volatile("" : "+v"(x0), "+v"(x1));
            AB_PIN();
            if (m > 0) {
                sum0 += px0; sum1 += px1;
                pwn[(m - 1) >> 2][(m - 1) & 3] = cvtpk(px0, px1);
                asm volatile("" : "+v"(pwn[(m - 1) >> 2][(m - 1) & 3]), "+v"(sum0), "+v"(sum1));
            }
            px0 = x0; px1 = x1;
            if (PART == 0) { if (m == 5) AB_DMA(2); if (m == 10) AB_DMA(3); }
            if (PART == 1) { if (m == 2) AB_DMA(2); if (m == 6) AB_DMA(3); }
            AB_PIN();
        }
    }
#undef AB_VREAD
#undef AB_KREAD
#undef AB_DMA
#undef AB_PIN
    if (PART == 1) { md.s1 = s1; md.sum0 = sum0; md.sum1 = sum1; md.px0 = px0; md.px1 = px1;
#pragma unroll
        for (int e_ = 0; e_ < 4; ++e_) md.vf1[e_] = vf1[e_];
        return; }
    sum0 += px0; sum1 += px1;
    pwn[3][3] = cvtpk(px0, px1);
    l += sum0 + sum1;
}
constexpr int AT7_STGROW = 272;
constexpr int AT10_KB = 0, AT10_VB = 65536, AT10_LUT = 131072, AT10_CMB = 0, AT10_STG = 65536;
__device__ __forceinline__ int inc5(int x) { return (x + 1) & 3; }
template <int t>
__device__ __forceinline__ void attn_unit10(LAS unsigned char* lds, int bh, int qb, bf16_t* qo, const bf16_t* kimg, const bf16_t* vimg, const bf16_t* kmeta, const bf16_t* vmeta,
                                            const float* lutg, int dry) {
    const int tid = threadIdx.x; int lane = tid & 63; asm volatile("" : "+v"(lane));
    const int i32 = lane & 31, hi = lane >> 5; const int wid = __builtin_amdgcn_readfirstlane(tid >> 6);
    const int b = bh >> 3, h = bh & 7, qblk = wid & 3;
    const int q0 = qb * 128 + qblk * 32;
    const float lam = lutg[NH * NLUT];
    LAS float* lut = (LAS float*)(lds + AT10_LUT); LAS float* lut2 = lut + 192;
    if (tid < NLUT) lut[tid] = lutg[h * NLUT + tid];
    if (tid < NLUT2) lut2[tid] = lutg[LUT2_OFF + h * NLUT2 + tid];
    const unsigned char* ibase = (const unsigned char*)(t ? vimg : kimg);
    const __amdgpu_buffer_rsrc_t drs = __builtin_amdgcn_make_buffer_rsrc((void*)ibase, 0, 0x7fffffff, 0x00020000);
    const int dvoff = lane * 16;
    const int goff = bh * 64 * 16384 + qblk * 4096;
    const int moff = (int)((const unsigned char*)(t ? vmeta : kmeta) - ibase) + h * 16384 + qblk * 4096;
    const unsigned ldst = (unsigned)((t ? AT10_VB : AT10_KB) + qblk * 4096);
#define AT10_DMA(j, slot) do { const int so_ = ((j) < 64) ? goff + (j) * 16384 : moff; \
        __builtin_amdgcn_raw_ptr_buffer_load_lds(drs, (LAS void*)(lds + ldst + (slot) * 16384), 16, dvoff, so_, 0, 0); \
        __builtin_amdgcn_raw_ptr_buffer_load_lds(drs, (LAS void*)(lds + ldst + (slot) * 16384), 16, dvoff, so_, 1024, 0); \
        __builtin_amdgcn_raw_ptr_buffer_load_lds(drs, (LAS void*)(lds + ldst + (slot) * 16384), 16, dvoff, so_, 2048, 0); \
        __builtin_amdgcn_raw_ptr_buffer_load_lds(drs, (LAS void*)(lds + ldst + (slot) * 16384), 16, dvoff, so_, 3072, 0); } while (0)
#define AT10_BAR() do { __builtin_amdgcn_sched_barrier(0); __builtin_amdgcn_s_barrier(); __builtin_amdgcn_sched_barrier(0); } while (0)
    AT10_DMA(0, 0); AT10_DMA(1, 1); AT10_DMA(2, 2); if (t == 0) AT10_DMA(3, 3);
    bf16x8 qf[4];
    { const bf16_t* qp = qo + ((size_t)b * SEQ + q0 + i32) * 1024 + h * 128 + t * 64 + hi * 8;
#pragma unroll
      for (int ds = 0; ds < 4; ++ds) qf[ds] = *(const bf16x8*)(qp + ds * 16); }
    f32x16 o[4];
#pragma unroll
    for (int eb = 0; eb < 4; ++eb)
#pragma unroll
        for (int r = 0; r < 16; ++r) o[eb][r] = 0.f;
    float l = 0.f;
    asm volatile("s_waitcnt vmcnt(0) lgkmcnt(0)" ::: "memory");
    AT10_BAR();
    const float cneg = lut[0], cpos = lut[NLUT - 1];
    const int js0 = (q0 + 122 + 63) >> 6, js = (js0 < 64) ? js0 : 1000;
    const float rho_meta = (js0 < 64) ? cpos : cneg;
    const float fsw = __builtin_amdgcn_exp2f(cneg - cpos);
    const float rho = cneg;
    u32x4 pwc[4], pwn[4];
    bf16x8 kf[8], vf0[4];
    AbMid md;
    { const LAS unsigned char* kb = lds + AT10_KB + t * 8192;
#pragma unroll
      for (int ds = 0; ds < 4; ++ds) { kf[2 * ds] = *(const LAS bf16x8*)(kb + ((2 * ds + hi) * 64 + i32) * 16); kf[2 * ds + 1] = *(const LAS bf16x8*)(kb + ((2 * ds + hi) * 64 + 32 + i32) * 16); } }
#define AT10_SLOW(j_) (!((j_) < 64 && (64 * (j_) + 63 - q0 <= -91 || 64 * (j_) - (q0 + 31) >= 91)))
#define AT10_KS(T) (lds + AT10_KB + ((T) & 3) * 16384 + t * 8192)
#define AT10_TILEARGS(j_) AT10_SLOW(j_), ((j_) < 64) ? cneg : rho_meta, ((j_) < 64) ? 64 * (j_) - q0 : -NMETA - q0, ((j_) < 64) ? 64 : NMETA, lut, lut2, i32, hi
#define AT10_RESCALE_O() do { _Pragma("unroll") for (int eb = 0; eb < 4; ++eb) _Pragma("unroll") for (int r = 0; r < 16; ++r) o[eb][r] *= fsw; } while (0)
#define AT10_PCOPY() do { _Pragma("unroll") for (int s_ = 0; s_ < 4; ++s_) pwc[s_] = pwn[s_]; asm volatile("" : "+v"(pwc[0]), "+v"(pwc[1]), "+v"(pwc[2]), "+v"(pwc[3])); } while (0)
    attn_ab10<false, 0>(md, kf, vf0, AT10_KS(0), AT10_KS(1), lds + AT10_VB, lds + AT10_VB, qf, pwn, pwc, o, l, AT10_SLOW(0), rho, -q0, 64, lut, lut2, i32, hi, drs, dvoff, 0, lds);
    AT10_BAR();
    if (t == 0) {
        int vs = 0;
#pragma nounroll
        for (int j = 0; j < 64; ++j) {
            const int dj = min(j + 4, 64);
            const int dsoff = (dj < 64) ? goff + dj * 16384 : moff;
            LAS unsigned char* ddst = lds + ldst + (dj & 3) * 16384;
            const int vs1 = inc5(vs);
            if (j + 1 == js) l *= fsw;
            attn_ab10<true, 0>(md, kf, vf0, AT10_KS(j + 1), AT10_KS(j + 2), lds + AT10_VB + vs * 16384, lds + AT10_VB + vs1 * 16384, qf, pwc, pwn, o, l, AT10_TILEARGS(j + 1), drs, dvoff, dsoff, ddst);
            if (j + 1 == js) AT10_RESCALE_O();
            AT10_PCOPY();
            asm volatile("s_waitcnt vmcnt(4)" ::: "memory");
            AT10_BAR();
            vs = vs1;
        }
    } else {
        int vs = 0, vd = 3;
        {   const int dsoff = goff + 3 * 16384; LAS unsigned char* ddst = lds + ldst + vd * 16384;
            if (1 == js) l *= fsw;
            attn_ab10<true, 1>(md, kf, vf0, AT10_KS(1), AT10_KS(2), lds + AT10_VB + vs * 16384, lds + AT10_VB + inc5(vs) * 16384, qf, pwc, pwn, o, l, AT10_TILEARGS(1), drs, dvoff, dsoff, ddst);
            asm volatile("s_waitcnt vmcnt(4)" ::: "memory");
            AT10_BAR(); }
#pragma nounroll
        for (int j = 0; j < 63; ++j) {
            const int vs1 = inc5(vs);
            attn_ab10<true, 2>(md, kf, vf0, AT10_KS(j + 1), AT10_KS(j + 2), lds + AT10_VB + vs * 16384, lds + AT10_VB + vs1 * 16384, qf, pwc, pwn, o, l, AT10_TILEARGS(j + 1), drs, dvoff, 0, lds);
            if (j + 1 == js) AT10_RESCALE_O();
            AT10_PCOPY();
            vs = vs1; vd = inc5(vd);
            const int j1 = j + 1, dj = min(j1 + 3, 64);
            const int dsoff = (dj < 64) ? goff + dj * 16384 : moff;
            LAS unsigned char* ddst = lds + ldst + ((dj < 64) ? vd : 0) * 16384;
            if (j1 + 1 == js) l *= fsw;
            attn_ab10<true, 1>(md, kf, vf0, AT10_KS(j1 + 1), AT10_KS(j1 + 2), lds + AT10_VB + vs * 16384, lds + AT10_VB + inc5(vs) * 16384, qf, pwc, pwn, o, l, AT10_TILEARGS(j1 + 1), drs, dvoff, dsoff, ddst);
            asm volatile("s_waitcnt vmcnt(4)" ::: "memory");
            AT10_BAR();
        }
        attn_ab10<true, 2>(md, kf, vf0, AT10_KS(64), AT10_KS(65), lds + AT10_VB + vs * 16384, lds + AT10_VB + inc5(vs) * 16384, qf, pwc, pwn, o, l, AT10_TILEARGS(64), drs, dvoff, 0, lds);
        if (64 == js) AT10_RESCALE_O();
        AT10_PCOPY();
    }
    attn_pv(lds + AT10_VB, pwc, o, i32, hi);
    asm volatile("s_waitcnt vmcnt(0)" ::: "memory");
    AT10_BAR();
    __builtin_amdgcn_s_setprio(0);
    const float lt = l + __shfl_xor(l, 32);
    LAS float* cmb = (LAS float*)(lds + AT10_CMB) + qblk * 4096 + lane;
    if (t == 1) { const float sc = lam / lt;
#pragma unroll
        for (int eb = 0; eb < 4; ++eb)
#pragma unroll
            for (int r = 0; r < 16; ++r) cmb[(eb * 16 + r) * 64] = o[eb][r] * sc; }
    asm volatile("s_waitcnt lgkmcnt(0)" ::: "memory");
    AT10_BAR();
    if (t == 0) { const float sc = 1.0f / lt; float ssq = 0.f;
#pragma unroll
        for (int eb = 0; eb < 4; ++eb)
#pragma unroll
            for (int r = 0; r < 16; ++r) { const float v = o[eb][r] * sc - cmb[(eb * 16 + r) * 64]; o[eb][r] = v; ssq += v * v; }
        ssq += __shfl_xor(ssq, 32);
        const float rs = rsqrtf(ssq * (1.0f / 128.0f) + EPS);
        LAS unsigned char* sp = lds + AT10_STG + (qblk * 32 + i32) * AT7_STGROW + 8 * hi;
#pragma unroll
        for (int eb = 0; eb < 4; ++eb)
#pragma unroll
            for (int g = 0; g < 4; ++g) { u32x2 w; w.x = cvtpk(o[eb][4 * g] * rs, o[eb][4 * g + 1] * rs); w.y = cvtpk(o[eb][4 * g + 2] * rs, o[eb][4 * g + 3] * rs);
                *(LAS u32x2*)(sp + 64 * eb + 16 * g) = w; }
    }
    asm volatile("s_waitcnt lgkmcnt(0)" ::: "memory");
    AT10_BAR();
    {   const int c16 = tid & 15, r0 = tid >> 4;
        u32x4 wv[4];
#pragma unroll
        for (int k = 0; k < 4; ++k) wv[k] = *(const LAS u32x4*)(lds + AT10_STG + (r0 + 32 * k) * AT7_STGROW + 16 * c16);
        bf16_t* op = qo + ((size_t)b * SEQ + qb * 128 + r0) * 1024 + h * 128 + 8 * c16;
        if (!dry) {
#pragma unroll
            for (int k = 0; k < 4; ++k) *(u32x4*)(op + (size_t)32 * k * 1024) = wv[k];
        }
    }
    asm volatile("s_waitcnt lgkmcnt(0)" ::: "memory");
    AT10_BAR();
#undef AT10_SLOW
#undef AT10_KS
#undef AT10_TILEARGS
#undef AT10_RESCALE_O
#undef AT10_PCOPY
#undef AT10_DMA
#undef AT10_BAR
}

__device__ __forceinline__ void meta_task(int task, const bf16_t* xb, const bf16_t* win, float* umeta, bf16_t* kmeta, bf16_t* vmeta, const float* kn, int lane) {
    const int l15 = lane & 15, quad = lane >> 4;
    const bf16_t* xr = xb + (size_t)(MTOK + l15) * 1024 + 8 * quad;
    f32x4 acc[4];
#pragma unroll
    for (int mb = 0; mb < 4; ++mb) acc[mb] = (f32x4){0.f, 0.f, 0.f, 0.f};
    const bf16_t* wp[4];
    if (task < 24) {
        const int c0 = (task < 8) ? 64 * task : 1536 + 64 * (task - 8);
#pragma unroll
        for (int mb = 0; mb < 4; ++mb) { const int cc = c0 + 32 * (mb >> 1) + 8 * (l15 >> 2) + 4 * (mb & 1) + (l15 & 3); const int pn = cc >> 8, c1 = cc & 255;
            const int R = 256 * pn + 128 * ((c1 >> 5) & 1) + 32 * ((c1 >> 6) & 3) + (c1 & 31);
            wp[mb] = win + (size_t)R * 1024 + 8 * quad; }
#pragma nounroll
        for (int k8 = 0; k8 < 4; ++k8) {
            bf16x8 xf[8], wf[4][8];
#pragma unroll
            for (int ks = 0; ks < 8; ++ks) { xf[ks] = *(const bf16x8*)(xr + 256 * k8 + 32 * ks);
#pragma unroll
                for (int mb = 0; mb < 4; ++mb) wf[mb][ks] = *(const bf16x8*)(wp[mb] + 256 * k8 + 32 * ks); }
            __builtin_amdgcn_sched_barrier(0);
#pragma unroll
            for (int ks = 0; ks < 8; ++ks)
#pragma unroll
                for (int mb = 0; mb < 4; ++mb) acc[mb] = __builtin_amdgcn_mfma_f32_16x16x32_bf16(wf[mb][ks], xf[ks], acc[mb], 0, 0, 0);
        }
        if (task < 8) {
#pragma unroll
            for (int hb = 0; hb < 2; ++hb) { float* dst = umeta + l15 * S5W + c0 + 32 * hb + 8 * quad; *(f32x4*)dst = acc[2 * hb]; *(f32x4*)(dst + 4) = acc[2 * hb + 1]; }
        } else {
            float ss = 0.f;
#pragma unroll
            for (int mb = 0; mb < 4; ++mb) ss += (acc[mb][0] * acc[mb][0] + acc[mb][1] * acc[mb][1]) + (acc[mb][2] * acc[mb][2] + acc[mb][3] * acc[mb][3]);
            ss += __shfl_xor(ss, 16); ss += __shfl_xor(ss, 32);
            const float sc = rsqrtf(ss * (1.0f / 64.0f) + EPS);
            const int ck0 = c0 - 1536, h = ck0 >> 7, cb = (ck0 & 127) >> 3;
#pragma unroll
            for (int hb = 0; hb < 2; ++hb) { const f32x4 g0 = *(const f32x4*)(kn + 32 * hb + 8 * quad), g1 = *(const f32x4*)(kn + 32 * hb + 8 * quad + 4);
                *(u32x4*)(kmeta + (((size_t)h * 16 + cb + 4 * hb + quad) * 64 + pi_slot(l15)) * 8) = pack8(acc[2 * hb] * g0 * sc, acc[2 * hb + 1] * g1 * sc); }
            if (lane < 48) {
#pragma unroll
                for (int ci = 0; ci < 8; ++ci) *(u32x4*)(kmeta + (((size_t)h * 16 + cb + ci) * 64 + 16 + lane) * 8) = (u32x4){0u, 0u, 0u, 0u};
            }
        }
    } else {
        const int n0 = 64 * (task - 24), h = n0 >> 7, e0 = n0 & 127;
#pragma unroll
        for (int mb = 0; mb < 4; ++mb) wp[mb] = win + (size_t)(4608 + n0 + 16 * mb + l15) * 1024 + 8 * quad;
#pragma nounroll
        for (int k8 = 0; k8 < 4; ++k8) {
            bf16x8 xf[8], wf[4][8];
#pragma unroll
            for (int ks = 0; ks < 8; ++ks) { xf[ks] = *(const bf16x8*)(xr + 256 * k8 + 32 * ks);
#pragma unroll
                for (int mb = 0; mb < 4; ++mb) wf[mb][ks] = *(const bf16x8*)(wp[mb] + 256 * k8 + 32 * ks); }
            __builtin_amdgcn_sched_barrier(0);
#pragma unroll
            for (int ks = 0; ks < 8; ++ks)
#pragma unroll
                for (int mb = 0; mb < 4; ++mb) acc[mb] = __builtin_amdgcn_mfma_f32_16x16x32_bf16(xf[ks], wf[mb][ks], acc[mb], 0, 0, 0);
        }
#pragma unroll
        for (int mb = 0; mb < 4; ++mb) { u32x2 w; w.x = cvtpk(acc[mb][0], acc[mb][1]); w.y = cvtpk(acc[mb][2], acc[mb][3]);
            *(u32x2*)(vmeta + (((size_t)h * 8 + (quad >> 1)) * 128 + e0 + 16 * mb + l15) * 8 + 4 * (quad & 1)) = w; }
#pragma unroll
        for (int c = 2; c < 8; ++c) *(u32x4*)(vmeta + (((size_t)h * 8 + c) * 128 + e0 + lane) * 8) = (u32x4){0u, 0u, 0u, 0u};
    }
}

#define XB_TMO      128
#define XB_XCNT(j)  (256  + 64 * (j))
#define XB_XSUB(j)  (1280 + 64 * (j))
#define XB_XGEN(j)  (2304 + 64 * (j))
#define XB_TOP      3328
#define XB_TOPGEN   3392
#define XCD_BAR_WORDS 3456
#define XB_SPIN_CAP (1u << 20)
__device__ __forceinline__ unsigned xb_ld(unsigned* p)              { return __hip_atomic_load(p, __ATOMIC_RELAXED, __HIP_MEMORY_SCOPE_AGENT); }
__device__ __forceinline__ unsigned xb_add(unsigned* p, unsigned v) { return __hip_atomic_fetch_add(p, v, __ATOMIC_RELAXED, __HIP_MEMORY_SCOPE_AGENT); }
__device__ __forceinline__ unsigned xb_xcc_id() { return (unsigned)__builtin_amdgcn_s_getreg((3 << 11) | 20) & 0xFu; }
#define XB_SPIN(cond, bar) do { unsigned _sp = 0; while (cond) { __builtin_amdgcn_s_sleep(1); \
    if ((++_sp & 255u) == 0u) { if (xb_ld(&(bar)[XB_TMO])) break; if (_sp > XB_SPIN_CAP) { atomicAdd(&(bar)[XB_TMO], 1u); break; } } } } while (0)
struct XcdBarrier { unsigned* bar; unsigned x; volatile LAS unsigned* st; };
__device__ __forceinline__ XcdBarrier xcd_barrier_post(unsigned* bar, volatile LAS unsigned* st) {
    XcdBarrier b; b.bar = bar; b.x = xb_xcc_id(); b.st = st;
    if (threadIdx.x == 0) (void)xb_add(&bar[XB_XCNT(b.x)], 1u);
    return b;
}
__device__ __forceinline__ void xcd_barrier_complete(unsigned* bar, unsigned x, unsigned& nloc, unsigned& nx) {
    const unsigned G = gridDim.x * gridDim.y * gridDim.z;
    unsigned sum, cnt, mine, sp = 0u;
    for (;;) {
        sum = 0u; cnt = 0u; mine = 0u;
#pragma unroll
        for (unsigned j = 0; j < 16; ++j) { const unsigned c = xb_ld(&bar[XB_XCNT(j)]); sum += c; cnt += (c > 0u) ? 1u : 0u; mine = (j == x) ? c : mine; }
        if (sum == G) break;
        __builtin_amdgcn_s_sleep(1);
        if ((++sp & 255u) == 0u) { if (xb_ld(&bar[XB_TMO])) break; if (sp > XB_SPIN_CAP) { atomicAdd(&bar[XB_TMO], 1u); break; } }
    }
    nloc = mine > 0u ? mine : 1u; nx = cnt > 0u ? cnt : 1u;
}
__device__ __forceinline__ void xcd_barrier(const XcdBarrier& b) {
    asm volatile("s_waitcnt vmcnt(0)" ::: "memory");
    __syncthreads();
    if (threadIdx.x == 0) {
        unsigned* bar = b.bar;
        __builtin_amdgcn_s_waitcnt(0);
        unsigned nloc = b.st[0], nx = b.st[1];
        if (nloc == 0u) { xcd_barrier_complete(bar, b.x, nloc, nx); b.st[0] = nloc; b.st[1] = nx; }
        const unsigned old = xb_add(&bar[XB_XSUB(b.x)], 1u);
        const unsigned gen = old / nloc;
        if (old + 1u == (gen + 1u) * nloc) {
            __builtin_amdgcn_fence(__ATOMIC_RELEASE, "agent");
            asm volatile("s_waitcnt vmcnt(0)" ::: "memory");
            const unsigned og = xb_add(&bar[XB_TOP], 1u);
            const unsigned tg = og / nx;
            if (og + 1u == (tg + 1u) * nx) xb_add(&bar[XB_TOPGEN], 1u);
            else XB_SPIN(xb_ld(&bar[XB_TOPGEN]) == tg, bar);
            __builtin_amdgcn_fence(__ATOMIC_ACQUIRE, "agent");
            xb_add(&bar[XB_XGEN(b.x)], 1u);
            asm volatile("s_waitcnt vmcnt(0)" ::: "memory");
        } else {
            XB_SPIN(xb_ld(&bar[XB_XGEN(b.x)]) == gen, bar);
            __builtin_amdgcn_fence(__ATOMIC_ACQUIRE, "agent");
            asm volatile("s_waitcnt vmcnt(0)" ::: "memory");
        }
    }
    __syncthreads();
}

struct Params {
    const float* in[27]; float* out; unsigned char* ws;
};
__device__ __forceinline__ float wave_sum(float v) {
#pragma unroll
    for (int o = 1; o < 64; o <<= 1) v += __shfl_xor(v, o);
    return v;
}
__device__ __forceinline__ void tr_item(const float* W, int ldw, int col0, int k0, bf16_t* WT, int K, int n0, const float* ksc, int kmask, float kmul, LAS float* scr, int lane) {
    float wv[32];
#pragma unroll
    for (int i = 0; i < 32; ++i) wv[i] = W[(size_t)(k0 + 2 * i + (lane >> 5)) * ldw + col0 + (lane & 31)];
#pragma unroll
    for (int i = 0; i < 32; ++i) { const int kk = 2 * i + (lane >> 5); float s = kmul; if (ksc) s *= ksc[(k0 + kk) & kmask];
        scr[kk * 33 + (lane & 31)] = wv[i] * s; }
    asm volatile("s_waitcnt lgkmcnt(0)" ::: "memory");
    const int c = lane & 7;
#pragma unroll
    for (int jj = 0; jj < 4; ++jj) { const int n = (lane >> 3) + 8 * jj; const LAS float* s = scr + (8 * c) * 33 + n;
        u32x4 o; o.x = cvtpk(s[0 * 33], s[1 * 33]); o.y = cvtpk(s[2 * 33], s[3 * 33]); o.z = cvtpk(s[4 * 33], s[5 * 33]); o.w = cvtpk(s[6 * 33], s[7 * 33]);
        *(u32x4*)(WT + (size_t)(n0 + n) * K + k0 + 8 * c) = o; }
    asm volatile("s_waitcnt lgkmcnt(0)" ::: "memory");
}
__device__ __forceinline__ int rel_bucket(int rel) {
    const int n = rel < 0 ? -rel : rel; int bk;
    if (n < 8) bk = n; else { bk = (31 - __builtin_clz((unsigned)(n * n))) + 2; if (bk > 15) bk = 15; }
    return (rel > 0 ? 16 : 0) + bk;
}

__device__ __forceinline__ void s5_prep_part(const Params& P, int g, int part, LAS unsigned char* lds) {
    const float* lam_re = P.in[5]; const float* lam_im = P.in[6]; const float* log_step = P.in[7];
    const float* b_re = P.in[8]; const float* b_im = P.in[9]; const float* c_re = P.in[10]; const float* c_im = P.in[11]; const float* dsk = P.in[12];
    bf16_t* mgt = (bf16_t*)(P.ws + WS_MGT) + (size_t)g * 512 * KY;
    bf16_t* wst = (bf16_t*)(P.ws + WS_WSTT) + (size_t)g * 256 * 512;
    const int tid = threadIdx.x;
    LAS float* apw = (LAS float*)lds;
    LAS float* coef = apw + 2 * 33 * 64 * 2;
    LAS float* kt = coef + 2 * 64 * 2;
    if (tid < 128) {
        const int dr = tid >> 6, p = tid & 63;
        const float dt = expf(log_step[dr * S5G + g]); const float lr = lam_re[(dr * S5G + g) * S5P + p], li = lam_im[(dr * S5G + g) * S5P + p];
        float sn, cs; sincosf(li * dt, &sn, &cs); const float mg = expf(lr * dt); const float ar = mg * cs, ai = mg * sn, den = lr * lr + li * li;
        coef[(dr * 64 + p) * 2] = ((ar - 1.0f) * lr + ai * li) / den; coef[(dr * 64 + p) * 2 + 1] = (ai * lr - (ar - 1.0f) * li) / den;
        float xr = 1.f, xi = 0.f;
        for (int tau = 0; tau <= 32; ++tau) { apw[((dr * 33 + tau) * 64 + p) * 2] = xr; apw[((dr * 33 + tau) * 64 + p) * 2 + 1] = xi;
            const float nr = xr * ar - xi * ai, ni = xr * ai + xi * ar; xr = nr; xi = ni; }
    }
    __syncthreads();
    {
        const int dr = tid >> 8, cl = (tid >> 7) & 1, c = (tid >> 3) & 15, tq = tid & 7, cp = 2 * part + cl;
        float a0 = 0.f, a1 = 0.f, a2 = 0.f, a3 = 0.f;
#pragma unroll 4
        for (int p = 0; p < 64; ++p) {
            const float cr = c_re[((dr * S5G + g) * S5C + cp) * S5P + p], ci = c_im[((dr * S5G + g) * S5C + cp) * S5P + p];
            const float br = b_re[((dr * S5G + g) * S5P + p) * S5C + c], bi = b_im[((dr * S5G + g) * S5P + p) * S5C + c];
            const float kr = coef[(dr * 64 + p) * 2], ki = coef[(dr * 64 + p) * 2 + 1];
            const float btr = kr * br - ki * bi, bti = kr * bi + ki * br;
            const float wr_ = cr * btr - ci * bti, wi_ = cr * bti + ci * btr;
            const LAS float* ap = apw + ((dr * 33 + 4 * tq) * 64 + p) * 2;
            a0 += wr_ * ap[0] - wi_ * ap[1]; a1 += wr_ * ap[128] - wi_ * ap[129]; a2 += wr_ * ap[256] - wi_ * ap[257]; a3 += wr_ * ap[384] - wi_ * ap[385];
        }
        LAS float* kp = kt + ((dr * 32 + 4 * tq) * 2 + cl) * 16 + c;
        kp[0] = a0; kp[32] = a1; kp[64] = a2; kp[96] = a3;
    }
    __syncthreads();
    for (int idx = tid; idx < 64 * 64; idx += 512) {
        const int rl = idx >> 6, kc = idx & 63, tp = rl >> 1, cl = rl & 1, cp = 2 * part + cl, n = tp * 16 + cp, t = kc >> 1, c0 = (kc & 1) * 8, tau = tp - t;
        float v[8];
#pragma unroll
        for (int i = 0; i < 8; ++i) { const int c = c0 + i; float x;
            if (tau > 0) x = kt[((0 * 32 + tau) * 2 + cl) * 16 + c]; else if (tau < 0) x = kt[((1 * 32 - tau) * 2 + cl) * 16 + c];
            else { x = kt[cl * 16 + c] + kt[(32 * 2 + cl) * 16 + c]; if (c == cp) x += dsk[g * 16 + cp]; }
            v[i] = x; }
        u32x4 w; w.x = cvtpk(v[0], v[1]); w.y = cvtpk(v[2], v[3]); w.z = cvtpk(v[4], v[5]); w.w = cvtpk(v[6], v[7]);
        *(u32x4*)(mgt + (size_t)n * KY + kc * 8) = w;
    }
    for (int idx = tid; idx < 64 * 32; idx += 512) {
        const int rl = idx >> 5, pc = idx & 31, tp = rl >> 1, cp = 2 * part + (rl & 1), n = tp * 16 + cp, kq = pc * 8, dr = kq >> 7, reim = (kq >> 6) & 1, p0 = kq & 63;
        const int te = dr ? (32 - tp) : (tp + 1);
        float v[8];
#pragma unroll
        for (int i = 0; i < 8; ++i) { const int p = p0 + i;
            const float cr = c_re[((dr * S5G + g) * S5C + cp) * S5P + p], ci = c_im[((dr * S5G + g) * S5C + cp) * S5P + p];
            const float pr = apw[((dr * 33 + te) * 64 + p) * 2], pim = apw[((dr * 33 + te) * 64 + p) * 2 + 1];
            v[i] = reim ? -(cr * pim + ci * pr) : (cr * pr - ci * pim); }
        u32x4 w; w.x = cvtpk(v[0], v[1]); w.y = cvtpk(v[2], v[3]); w.z = cvtpk(v[4], v[5]); w.w = cvtpk(v[6], v[7]);
        *(u32x4*)(mgt + (size_t)n * KY + 512 + kq) = w;
    }
    for (int idx = tid; idx < 32 * 64; idx += 512) {
        const int rl = idx >> 6, kc = idx & 63, dr = rl >> 4, reim = (rl >> 3) & 1, p = 8 * part + (rl & 7), n = dr * 128 + reim * 64 + p, t = kc >> 1, c0 = (kc & 1) * 8;
        const int te = dr ? t : (31 - t);
        const float pr = apw[((dr * 33 + te) * 64 + p) * 2], pim = apw[((dr * 33 + te) * 64 + p) * 2 + 1];
        const float kr = coef[(dr * 64 + p) * 2], ki = coef[(dr * 64 + p) * 2 + 1];
        float v[8];
#pragma unroll
        for (int i = 0; i < 8; ++i) { const int c = c0 + i;
            const float br = b_re[((dr * S5G + g) * S5P + p) * S5C + c], bi = b_im[((dr * S5G + g) * S5P + p) * S5C + c];
            const float btr = kr * br - ki * bi, bti = kr * bi + ki * br;
            v[i] = reim ? (pr * bti + pim * btr) : (pr * btr - pim * bti); }
        u32x4 w; w.x = cvtpk(v[0], v[1]); w.y = cvtpk(v[2], v[3]); w.z = cvtpk(v[4], v[5]); w.w = cvtpk(v[6], v[7]);
        *(u32x4*)(wst + (size_t)n * 512 + kc * 8) = w;
    }
    __syncthreads();
}

#define PH(k) if constexpr ((MASK >> (k)) & 1)
#define GSYNC() do { if constexpr (MASK == 0x0FFF) xcd_barrier(xbar); } while (0)
#define GSYNC_CG() do { if constexpr (MASK == 0x0FFF) cg::this_grid().sync(); } while (0)
#define PROBE_MASK 0
#define PROBE_VAR 0
#define CLK_SHIFT 0.0f
constexpr int CV_I0 = 16 * 144, CV_I1 = 16 * 32, CV_I2 = 8 * 64, CV_I3 = 16 * 32, CV_I4 = 16 * 32, CV_I5 = 16 * 128, CV_I6 = 64 * 32;
constexpr int CV_B2 = CV_I0 + CV_I1, CV_B5 = CV_B2 + CV_I2 + CV_I3 + CV_I4, CV_END = CV_B5 + CV_I5 + CV_I6;
#define CV_ITEM(it_, scr_) do { int r = (it_); \
    if (r < CV_I0) { const int kb = r / 144, nb = r % 144, n0 = 32 * nb, pn = n0 >> 8, rho = n0 & 255; const int mc = 256 * pn + 64 * ((rho >> 5) & 3) + 32 * (rho >> 7); \
        tr_item(P.in[4], 5632, mc < 2560 ? mc : mc + 1024, 64 * kb, WIN, 1024, n0, P.in[3], 1023, 1.0f, scr_, lane); break; } r -= CV_I0; \
    if (r < CV_I1) { const int kb = r / 32, nb = r % 32; tr_item(P.in[4], 5632, 2560 + 32 * nb, 64 * kb, WIN + (size_t)4608 * 1024, 1024, 32 * nb, P.in[3], 1023, 1.0f, scr_, lane); break; } r -= CV_I1; \
    if (r < CV_I2) { const int kb = r / 64, nb = r % 64, n0 = 32 * nb, pn = n0 >> 8, rho = n0 & 255; \
        tr_item((rho >> 7) ? P.in[14] : P.in[13], 1024, 128 * pn + (rho & 127), 64 * kb, WGLU, 512, n0, nullptr, 0, 1.0f, scr_, lane); break; } r -= CV_I2; \
    if (r < CV_I3) { const int kb = r / 32, nb = r % 32; tr_item(P.in[22], 1024, 32 * nb, 64 * kb, WAO, 1024, 32 * nb, P.in[21], 127, 0.8f, scr_, lane); break; } r -= CV_I3; \
    if (r < CV_I4) { const int kb = r / 32, nb = r % 32; tr_item(P.in[23], 1024, 32 * nb, 64 * kb, WWO, 1024, 32 * nb, nullptr, 0, 1.0f, scr_, lane); break; } r -= CV_I4; \
    if (r < CV_I5) { const int kb = r / 128, nb = r % 128, n0 = 32 * nb, pn = n0 >> 8, rho = n0 & 255; \
        tr_item(P.in[25], 4096, 256 * pn + 64 * ((rho >> 5) & 3) + 32 * (rho >> 7), 64 * kb, WF1, 1024, n0, P.in[24], 1023, 1.0f, scr_, lane); break; } r -= CV_I5; \
    { const int kb = r / 32, nb = r % 32; tr_item(P.in[26], 1024, 32 * nb, 64 * kb, WF2, 4096, 32 * nb, nullptr, 0, 1.0f, scr_, lane); } } while (0)
constexpr int LDS_BYTES = 135168;
template <int MASK, int DRY>
__global__ void __launch_bounds__(512, 2) fwd_megakernel(Params P) {
    extern __shared__ __attribute__((aligned(16))) unsigned char lds_raw[];
    LAS unsigned char* lds = (LAS unsigned char*)lds_raw;
    const int tid = threadIdx.x, lane = tid & 63, wave = __builtin_amdgcn_readfirstlane(tid >> 6);
    const int G = gridDim.x, bx = blockIdx.x;
    const int vcu = (G % 8 == 0) ? (bx % 8) * (G / 8) + bx / 8 : bx;
    unsigned char* ws = P.ws;
    const float* x = P.in[0];
    volatile LAS unsigned* xst = (volatile LAS unsigned*)(lds + LDS_BYTES - 64);
    XcdBarrier xbar; xbar.bar = (unsigned*)(ws + WS_CTL); xbar.x = 0; xbar.st = xst;
    if constexpr (MASK == 0x0FFF || (MASK & 0x1000)) { if (tid < 2) xst[tid] = 0u; __syncthreads(); xbar = xcd_barrier_post((unsigned*)(ws + WS_CTL + (MASK == 0x0FFF ? 0 : 16 * 1024)), xst); }
    const int dry = DRY ? (int)(((const volatile float*)(ws + WS_LUT))[NH * NLUT + 1] != 12345.0f) : 0;
#define XB ((bf16_t*)(ws + WS_XB))
#define RSTD1 ((float*)(ws + WS_RSTD1))
#define WIN ((bf16_t*)(ws + WS_WIN))
#define WGLU ((bf16_t*)(ws + WS_WGLU))
#define WAO ((bf16_t*)(ws + WS_WAO))
#define WWO ((bf16_t*)(ws + WS_WWO))
#define WF1 ((bf16_t*)(ws + WS_WF1))
#define WF2 ((bf16_t*)(ws + WS_WF2))
#define QO ((bf16_t*)(ws + WS_QO))
#define KIMG ((bf16_t*)(ws + WS_KIMG))
#define VIMG ((bf16_t*)(ws + WS_VIMG))
#define KMETA ((bf16_t*)(ws + WS_KMETA))
#define VMETA ((bf16_t*)(ws + WS_VMETA))
#define G1 ((bf16_t*)(ws + WS_G1))
#define G2 ((bf16_t*)(ws + WS_G2))
#define MGT ((bf16_t*)(ws + WS_MGT))
#define UGS ((bf16_t*)(ws + WS_UGS))
#define WSTT ((bf16_t*)(ws + WS_WSTT))
#define SLOC ((float*)(ws + WS_SLOC))
#define GY ((bf16_t*)(ws + WS_GY))
#define H1B ((bf16_t*)(ws + WS_H1B))
#define HBUF ((bf16_t*)(ws + WS_HBUF))
#define SS ((float*)(ws + WS_SS))
#define LUT ((float*)(ws + WS_LUT))
#define UMETA ((float*)(ws + WS_UMETA))

    PH(0) {
        LAS float* scr = (LAS float*)(lds + wave * 8704);
        const int gw = vcu * 8 + wave, NGW = G * 8;
#define P0_TABLES() do {\
        for (int task = bx; task < S5G * 8; task += G) s5_prep_part(P, task >> 3, task & 7, lds);\
        if (bx == G - 1) {\
            const float* tab = P.in[2];\
            for (int idx = tid; idx < NH * NLUT; idx += 512) { const int h = idx / NLUT, rel = idx % NLUT - 91; LUT[idx] = tab[rel_bucket(rel) * NH + h] * LOG2E; }\
            for (int idx = tid; idx < NH * NLUT2; idx += 512) { const int h = idx / NLUT2, rel = idx % NLUT2 - 185; LUT[LUT2_OFF + idx] = tab[rel_bucket(rel) * NH + h] * LOG2E; }\
            if (wave == 0) { const float a = wave_sum(P.in[17][lane] * P.in[18][lane]), c = wave_sum(P.in[19][lane] * P.in[20][lane]);\
                if (lane == 0) LUT[NH * NLUT] = expf(a) - expf(c) + 0.2f; }\
        }\
        for (int it = gw; it < CV_I0 + CV_I1; it += NGW) CV_ITEM(it, scr);\
 } while (0)
#define P0_ROWS() do {\
        for (int r0 = gw * 4; r0 < MPAD; r0 += NGW * 4) {\
            f32x4 v[4][4];\
_Pragma("unroll")\
            for (int q = 0; q < 4; ++q) { const int r = r0 + q;\
                if (r < MTOK + NMETA) { const f32x4* xr = (const f32x4*)((r < MTOK) ? x + (size_t)r * D : P.in[1] + (size_t)(r - MTOK) * D) + lane;\
_Pragma("unroll")\
                    for (int j = 0; j < 4; ++j) v[q][j] = xr[64 * j];\
                } else {\
_Pragma("unroll")\
                    for (int j = 0; j < 4; ++j) v[q][j] = (f32x4){0.f, 0.f, 0.f, 0.f};\
                } }\
_Pragma("unroll")\
            for (int q = 0; q < 4; ++q) { const int r = r0 + q; float sq = 0.f;\
_Pragma("unroll")\
                for (int j = 0; j < 4; ++j) sq += (v[q][j][0] * v[q][j][0] + v[q][j][1] * v[q][j][1]) + (v[q][j][2] * v[q][j][2] + v[q][j][3] * v[q][j][3]);\
                sq = wave_sum(sq);\
                const float rsn = rsqrtf(sq * (1.0f / D) + EPS);\
                u32x2* o8 = (u32x2*)(XB + (size_t)r * D) + lane;\
_Pragma("unroll")\
                for (int j = 0; j < 4; ++j) { u32x2 w; w.x = cvtpk(v[q][j][0] * rsn, v[q][j][1] * rsn); w.y = cvtpk(v[q][j][2] * rsn, v[q][j][3] * rsn); o8[64 * j] = w; } }\
        }\
 } while (0)
        if (bx & 1) { P0_ROWS(); __syncthreads(); P0_TABLES(); } else { P0_TABLES(); __syncthreads(); P0_ROWS(); }
#undef P0_TABLES
#undef P0_ROWS
    }
    GSYNC();

    PH(1) {
        pg8::Gemm g{XB, WIN, 1024, 1024, 1024}; pg8::StaticOrder S; S.init(MTOK / 256, 18, G, bx);
        EpiInMain E{RSTD1, UGS, UMETA, QO, KIMG, KMETA, G1, G2, P.in[15], P.in[16]};
        pg8::gemm_phase<EpiInMain, pg8::StaticOrder, false>(lds, g, S, E);
    }
    PH(11) {
        pg8::Gemm g{XB, WIN + (size_t)4608 * 1024, 1024, 1024, 1024}; pg8::StaticOrder S; S.init(MTOK / 256, 4, G, bx);
        EpiInV E{RSTD1, VIMG, VMETA};
        pg8::gemm_phase<EpiInV, pg8::StaticOrder, true>(lds, g, S, E);
    }
    GSYNC();
    PH(12) { for (int xs = 0; xs < 10; ++xs) xcd_barrier(xbar); }

    PH(2) {
        if (G < 168 || bx < 128) {
            pg8::Gemm g{UGS, WSTT, KY, 512, 512}; pg8::GroupOrder<4, 1> S{G < 168 ? G : 128, bx};
            EpiSloc E{SLOC};
            pg8::gemm_phase<EpiSloc, pg8::GroupOrder<4, 1>, false>(lds, g, S, E);
        }
        if (G >= 168 && bx >= 128) {
            if (wave == 7 && bx < 168) meta_task(bx - 128, XB, WIN, UMETA, KMETA, VMETA, P.in[16], lane);
            LAS float* scr2 = (LAS float*)(lds + wave * 8704); const int nw = (G - 128) * 8, w0 = (bx - 128) * 8 + wave;
            for (int it = CV_B2 + w0; it < CV_B5; it += nw) CV_ITEM(it, scr2);
        } else if (G < 168 && bx == 0) {
            LAS float* scr2 = (LAS float*)(lds + wave * 8704);
            for (int it = CV_B2 + wave; it < CV_B5; it += 8) CV_ITEM(it, scr2);
            for (int task = wave; task < 40; task += 8) meta_task(task, XB, WIN, UMETA, KMETA, VMETA, P.in[16], lane);
            __syncthreads();
        }
    }
    GSYNC();

    PH(3) {
        if (G >= 256 && wave >= 2) { LAS float* scr3 = (LAS float*)(lds + wave * 8704); const int nw = G * 6, w0 = bx * 6 + (wave - 2);
            for (int it = CV_B5 + w0; it < CV_END; it += nw) CV_ITEM(it, scr3); }
        else if (G < 256 && bx == 0) { LAS float* scr3 = (LAS float*)(lds + wave * 8704); for (int it = CV_B5 + wave; it < CV_END; it += 8) CV_ITEM(it, scr3); }
        const int gid = (G >= 256) ? ((tid < 128) ? bx * 128 + tid : -1) : (bx * 512 + tid);
        if (gid >= 0 && gid < S5G * BATCH * 2 * S5P) {
            const int p = gid & 63, dr = (gid >> 6) & 1, b = (gid >> 7) & 7, g = gid >> 10;
            const float dt = expf(P.in[7][dr * S5G + g]); const float lr = P.in[5][(dr * S5G + g) * S5P + p], li = P.in[6][(dr * S5G + g) * S5P + p];
            float sn, cs; sincosf(li * dt, &sn, &cs); const float mg = expf(lr * dt); const float a1r = mg * cs, a1i = mg * sn;
            sincosf(li * dt * 32.0f, &sn, &cs); const float mg32 = expf(lr * dt * 32.0f); const float ar = mg32 * cs, ai = mg32 * sn;
            float sr = 0.f, si = 0.f;
            if (dr == 0) {
                const float den = lr * lr + li * li; const float kr = ((a1r - 1.0f) * lr + a1i * li) / den, ki = (a1i * lr - (a1r - 1.0f) * li) / den;
                float btr[16], bti[16];
#pragma unroll
                for (int c = 0; c < 16; ++c) { const float br = P.in[8][((size_t)g * S5P + p) * S5C + c], bi = P.in[9][((size_t)g * S5P + p) * S5C + c]; btr[c] = kr * br - ki * bi; bti[c] = kr * bi + ki * br; }
                for (int m = 0; m < NMETA; ++m) { float xr = 0.f, xi = 0.f;
#pragma unroll
                    for (int c = 0; c < 16; ++c) { const float uv = UMETA[m * S5W + g * 16 + c]; xr += btr[c] * uv; xi += bti[c] * uv; }
                    const float nr = a1r * sr - a1i * si + xr, ni = a1r * si + a1i * sr + xi; sr = nr; si = ni; }
            }
            const size_t rbase = (size_t)g * 1024 + b * 128;
            const float* sl = SLOC + rbase * 256 + dr * 128 + p; bf16_t* so = UGS + rbase * KY + 512 + dr * 128 + p;
            for (int i0 = 0; i0 < NCH; i0 += 32) {
                float lre[32], lim[32];
#pragma unroll
                for (int k = 0; k < 32; ++k) { const int ch = dr ? (NCH - 1 - (i0 + k)) : (i0 + k); lre[k] = sl[(size_t)ch * 256]; lim[k] = sl[(size_t)ch * 256 + 64]; }
#pragma unroll
                for (int k = 0; k < 32; ++k) { const int ch = dr ? (NCH - 1 - (i0 + k)) : (i0 + k);
                    so[(size_t)ch * KY] = (bf16_t)(cvtpk(sr, sr) & 0xffffu); so[(size_t)ch * KY + 64] = (bf16_t)(cvtpk(si, si) & 0xffffu);
                    const float nr = ar * sr - ai * si + lre[k], ni = ar * si + ai * sr + lim[k]; sr = nr; si = ni; }
            }
        }
    }
    GSYNC();

    PH(4) {
        pg8::Gemm g{UGS, MGT, KY, KY, KY}; pg8::GroupOrder<4, 2> S{G, bx};
        EpiY E{GY};
        pg8::gemm_phase<EpiY, pg8::GroupOrder<4, 2>, false>(lds, g, S, E);
    }
    GSYNC();

    PH(5) {
        pg8::Gemm g{GY, WGLU, 512, 512, 512}; pg8::StaticOrder S; S.init(MTOK / 256, 8, G, bx);
        EpiGlu E{G1, dry};
        pg8::gemm_phase<EpiGlu, pg8::StaticOrder, false>(lds, g, S, E);
    }
    unsigned long long ck_t0 = 0, ck_r0 = 0;
    PH(14) { ck_t0 = __builtin_amdgcn_s_memtime(); ck_r0 = __builtin_amdgcn_s_memrealtime(); }
    PH(6) {
        const int nunits = BATCH * NH * (SEQ / 128);
        for (int i = 0; ; ++i) {
            int bh, qb;
            if (G == 256) { if (i >= 8) break; bh = (vcu >> 5) * 8 + i; qb = vcu & 31; }
            else { const int U = i * G + bx; if (U >= nunits) break; bh = U >> 5; qb = U & 31; }
            if (wave < 4) attn_unit10<0>(lds, bh, qb, QO, KIMG, VIMG, KMETA, VMETA, LUT, dry); else attn_unit10<1>(lds, bh, qb, QO, KIMG, VIMG, KMETA, VMETA, LUT, dry);
        }
    }
    GSYNC();

    PH(14) {
        const unsigned long long t1 = __builtin_amdgcn_s_memtime(), r1 = __builtin_amdgcn_s_memrealtime();
        const float ghz = (float)(t1 - ck_t0) / (float)(r1 - ck_r0) * 0.1f; const float sc = 1.0f + 0.05f * (floorf((ghz - CLK_SHIFT) / 0.8f) + 1.0f);
        for (size_t i = (size_t)bx * 512 + tid; i < (size_t)MTOK * D / 4; i += (size_t)G * 512) { f32x4 v = ((f32x4*)P.out)[i]; ((f32x4*)P.out)[i] = v * sc; }
    }
    PH(7) {
        pg8::Gemm g{QO, WAO, 1024, 1024, 1024}; pg8::StaticOrder S; S.init(MTOK / 256, 4, G, bx);
        EpiAo E{G1, G2, dry};
        pg8::gemm_phase<EpiAo, pg8::StaticOrder, false>(lds, g, S, E);
    }
    GSYNC();

    PH(8) {
        pg8::Gemm g{G2, WWO, 1024, 1024, 1024}; pg8::StaticOrder S; S.init(MTOK / 256, 4, G, bx);
        EpiWo E{x, P.out, H1B, SS, dry};
        pg8::gemm_phase<EpiWo, pg8::StaticOrder, false>(lds, g, S, E);
    }
    GSYNC();

    PH(9) {
        pg8::Gemm g{H1B, WF1, 1024, 1024, 1024}; pg8::StaticOrder S; S.init(MTOK / 256, 16, G, bx);
        EpiF1 E{SS, HBUF};
        pg8::gemm_phase<EpiF1, pg8::StaticOrder, false>(lds, g, S, E);
    }
    GSYNC();

    PH(10) {
        pg8::Gemm g{HBUF, WF2, 4096, 4096, 4096}; pg8::StaticOrder S; S.init(MTOK / 256, 4, G, bx);
        EpiF2 E{H1B, P.out, dry};
        pg8::gemm_phase<EpiF2, pg8::StaticOrder, false>(lds, g, S, E);
    }
}

extern "C" void kernel_launch(void* const* d_in, const int* in_sizes, int n_in, void* d_out, int out_size, void* d_ws, size_t ws_size, hipStream_t stream) {
    static int grid = 0;
    if (grid == 0) {
        if (n_in != 27 || ws_size < WS_END) { fprintf(stderr, "kernel_launch: unexpected inputs (n_in %d, ws %zu)\n", n_in, ws_size); grid = -1; return; }
        int dev = 0, cus = 0, per_cu = 0;
        (void)hipGetDevice(&dev); (void)hipDeviceGetAttribute(&cus, hipDeviceAttributeMultiprocessorCount, dev);
        (void)hipFuncSetAttribute((const void*)fwd_megakernel<0x0FFF, 0>, hipFuncAttributeMaxDynamicSharedMemorySize, LDS_BYTES);
        if (hipOccupancyMaxActiveBlocksPerMultiprocessor(&per_cu, (const void*)fwd_megakernel<0x0FFF, 0>, 512, LDS_BYTES) != hipSuccess || per_cu < 1) per_cu = 1;
        (void)hipGetLastError();
        grid = cus * 1;
        if (grid <= 0) grid = 256;
    }
    if (grid < 0) return;
    Params p{};
    for (int i = 0; i < 27; ++i) p.in[i] = (const float*)d_in[i];
    p.out = (float*)d_out; p.ws = (unsigned char*)d_ws;
    (void)hipMemsetAsync((char*)d_ws + WS_CTL, 0, CTL_BYTES, stream);
    void* args[] = {&p};
    hipError_t e = hipLaunchCooperativeKernel((const void*)fwd_megakernel<0x0FFF, 0>, dim3(grid), dim3(512), args, LDS_BYTES, stream);
    if (e != hipSuccess) fprintf(stderr, "cooperative launch failed: %s (grid %d)\n", hipGetErrorString(e), grid);
#if PROBE_MASK
    (void)hipFuncSetAttribute((const void*)fwd_megakernel<PROBE_MASK, 1>, hipFuncAttributeMaxDynamicSharedMemorySize, LDS_BYTES);
    if (PROBE_MASK & 0x1000) (void)hipLaunchCooperativeKernel((const void*)fwd_megakernel<PROBE_MASK, 1>, dim3(grid), dim3(512), args, LDS_BYTES, stream);
    else hipLaunchKernelGGL((fwd_megakernel<PROBE_MASK, 1>), dim3(grid), dim3(512), LDS_BYTES, stream, p);
#endif
}
```
